# Optimizing an MI355X kernel written in HIP

```python
import math
import jax, jax.numpy as jnp
from jax import lax
import numpy as np

D_MODEL = 1024
BATCH = 4
SEQ = 8192
DEPTH = 4

GRID_W = 64
CTX_LEN = 256
N_MIXERS = 2
A_HEADS = 4
A_DK = 128
A_DV = 256
N_DIR = 2
CHUNK = 64
D_FF = 2816
EPS = 1e-6
A_PROJ = 2 * A_HEADS * A_DK + A_HEADS * A_DV + D_MODEL + 2 * N_DIR * A_HEADS
N_A = sum(1 for i in range(DEPTH) if i % N_MIXERS == 0)
N_B = DEPTH - N_A

kernel_name = "hybrid_mlstm_shortconv_convglu_prefix_dit"


def rmsnorm(x, g):
    xf = x.astype(jnp.float32)
    y = xf * lax.rsqrt(jnp.mean(xf * xf, axis=-1, keepdims=True) + EPS)
    return (y * g.astype(jnp.float32)).astype(x.dtype)


def modulate(x, g, shift, scale):
    return rmsnorm(x, g) * (1 + scale) + shift


def conv3(x, w, axis):
    pad = [(0, 0)] * x.ndim
    pad[axis] = (1, 1)
    xp = jnp.pad(x, pad)
    n = x.shape[axis]
    sl = lambda s: lax.slice_in_dim(xp, s, s + n, axis=axis)
    return sl(0) * w[0] + sl(1) * w[1] + sl(2) * w[2]


def mlstm_inputs(h, w_in, b_gate):
    bn, t, _ = h.shape
    p = h @ w_in
    o1 = A_HEADS * A_DK
    o2 = 2 * o1
    o3 = o2 + A_HEADS * A_DV
    o4 = o3 + D_MODEL
    heads = lambda a, d: a.reshape(bn, t, A_HEADS, d).transpose(0, 2, 1, 3).astype(jnp.float32)
    q = heads(p[..., :o1], A_DK)
    k = heads(p[..., o1:o2], A_DK) * (A_DK ** -0.5)
    v = heads(p[..., o2:o3], A_DV)
    o = p[..., o3:o4]
    gates = (p[..., o4:] + b_gate).astype(jnp.float32)
    gates = gates.reshape(bn, t, 2, N_DIR, A_HEADS).transpose(2, 3, 0, 4, 1)
    it = gates[0]
    lf = jax.nn.log_sigmoid(gates[1])
    return q, k, v, it, lf, o


def mlstm_chunk_scan(q, k, v, it, lf, state, emit):
    bn, nh, t, _ = q.shape
    nc = t // CHUNK
    chunks = lambda a: jnp.moveaxis(a.reshape(a.shape[:2] + (nc, CHUNK) + a.shape[3:]), 2, 0)
    xs = (chunks(q), chunks(k), chunks(v), chunks(it), chunks(lf))
    mask = jnp.tril(jnp.ones((CHUNK, CHUNK), dtype=bool))

    def body(carry, inp):
        cm, nv, m = carry
        qc, kc, vc, ic, fc = inp
        b = jnp.cumsum(fc, axis=-1)
        g = b[..., -1]
        a = g[..., None] - b + ic
        m_new = jnp.maximum(g + m, jnp.max(a, axis=-1))
        decay = jnp.exp(g + m - m_new)
        wa = jnp.exp(a - m_new[..., None])
        c_new = decay[..., None, None] * cm + jnp.einsum('bhsv,bhsd->bhvd', wa[..., None] * vc, kc)
        n_new = decay[..., None] * nv + jnp.einsum('bhs,bhsd->bhd', wa, kc)
        if not emit:
            return (c_new, n_new, m_new), None
        dmat = jnp.where(mask, b[..., :, None] - b[..., None, :] + ic[..., None, :], -jnp.inf)
        inter = b + m[..., None]
        m_t = jnp.maximum(inter, jnp.max(dmat, axis=-1))
        w = jnp.exp(dmat - m_t[..., None]) * jnp.einsum('bhtd,bhsd->bhts', qc, kc)
        wi = jnp.exp(inter - m_t)
        num = jnp.einsum('bhts,bhsv->bhtv', w, vc) + wi[..., None] * jnp.einsum('bhvd,bhtd->bhtv', cm, qc)
        den = jnp.sum(w, axis=-1) + wi * jnp.einsum('bhd,bhtd->bht', nv, qc)
        h = num / jnp.maximum(jnp.abs(den), jnp.exp(-m_t))[..., None]
        return (c_new, n_new, m_new), h

    state, hs = lax.scan(body, state, xs)
    if not emit:
        return None, state
    return jnp.moveaxis(hs, 0, 2).reshape(bn, nh, t, A_DV), state


def mlstm_readout(h, o, gain, w_out):
    bn, nh, t, dv = h.shape
    hn = h * lax.rsqrt(jnp.mean(h * h, axis=-1, keepdims=True) + EPS)
    hn = hn.transpose(0, 2, 1, 3).reshape(bn, t, nh * dv) * gain.astype(jnp.float32)
    y = hn * jax.nn.sigmoid(o.astype(jnp.float32))
    return y.astype(o.dtype) @ w_out


def mlstm_mixer(h_lat, h_ctx, w_in, b_gate, head_gain, w_out, emit_ctx):
    ql, kl, vl, il, fl, ol = mlstm_inputs(h_lat, w_in, b_gate)
    qc, kc, vc, ic, fc, oc = mlstm_inputs(h_ctx, w_in, b_gate)
    bn = h_lat.shape[0]
    s0 = (jnp.zeros((bn, A_HEADS, A_DV, A_DK), jnp.float32),
          jnp.zeros((bn, A_HEADS, A_DK), jnp.float32),
          jnp.zeros((bn, A_HEADS), jnp.float32))
    rq = lambda a: jnp.flip(a, axis=2)
    rg = lambda a: jnp.flip(a, axis=-1)
    hc_f, s_f = mlstm_chunk_scan(qc, kc, vc, ic[0], fc[0], s0, emit_ctx)
    hl_f, _ = mlstm_chunk_scan(ql, kl, vl, il[0], fl[0], s_f, True)
    hc_b, s_b = mlstm_chunk_scan(rq(qc), rq(kc), rq(vc), rg(ic[1]), rg(fc[1]), s0, emit_ctx)
    hl_b, _ = mlstm_chunk_scan(rq(ql), rq(kl), rq(vl), rg(il[1]), rg(fl[1]), s_b, True)
    y = mlstm_readout(hl_f + rq(hl_b), ol, head_gain, w_out)
    yc = mlstm_readout(hc_f + rq(hc_b), oc, head_gain, w_out) if emit_ctx else None
    return y, yc


def shortconv_mixer(h, w_in, w_conv, w_out, conv_fn):
    bg, cg, xv = jnp.split(h @ w_in, 3, axis=-1)
    return (bg * conv_fn(cg * xv, w_conv)) @ w_out


def conv_glu(h, w_up, w_conv, b_conv, w_down, conv_fn):
    gate, val = jnp.split(h @ w_up, 2, axis=-1)
    gate = conv_fn(gate, w_conv) + b_conv
    return (jax.nn.silu(gate) * val) @ w_down


def setup_inputs(seed: int = 0) -> dict:
    key = jax.random.key(seed)
    ks = jax.random.split(key, 24)
    nrm = lambda k, s, sc: jax.random.normal(k, s, jnp.float32) * sc
    D = D_MODEL
    b_i = nrm(ks[10], (N_A, N_DIR, A_HEADS), 0.1)
    b_f = jnp.linspace(3.0, 6.0, A_HEADS, dtype=jnp.float32) + nrm(ks[11], (N_A, N_DIR, A_HEADS), 0.1)
    a_b_gate = jnp.stack([b_i, b_f], axis=1).reshape(N_A, 2 * N_DIR * A_HEADS)
    return {
        "x": nrm(ks[0], (BATCH, SEQ, D), 1.0),
        "c": nrm(ks[1], (BATCH, D), 1.0),
        "ctx": nrm(ks[2], (BATCH, CTX_LEN, D), 1.0),
        "c_ctx": nrm(ks[3], (D,), 1.0),
        "w_mod": nrm(ks[4], (DEPTH, D, 6 * D), 0.5 * D ** -0.5),
        "b_mod": nrm(ks[5], (DEPTH, 6 * D), 0.02),
        "g_mix": 1.0 + nrm(ks[6], (DEPTH, D), 0.05),
        "g_ffn": 1.0 + nrm(ks[7], (DEPTH, D), 0.05),
        "a_w_in": nrm(ks[8], (N_A, D, A_PROJ), D ** -0.5),
        "a_b_gate": a_b_gate,
        "a_head_gain": 1.0 + nrm(ks[9], (N_A, A_HEADS * A_DV), 0.05),
        "a_w_out": nrm(ks[12], (N_A, A_HEADS * A_DV, D), (A_HEADS * A_DV) ** -0.5),
        "b_w_in": nrm(ks[13], (N_B, D, 3 * D), D ** -0.5),
        "b_w_conv": nrm(ks[14], (N_B, 3, D), 3 ** -0.5),
        "b_w_out": nrm(ks[15], (N_B, D, D), D ** -0.5),
        "f_w_up": nrm(ks[16], (DEPTH, D, 2 * D_FF), D ** -0.5),
        "f_w_conv": nrm(ks[17], (DEPTH, 3, D_FF), 3 ** -0.5),
        "f_b_conv": nrm(ks[18], (DEPTH, D_FF), 0.02),
        "f_w_down": nrm(ks[19], (DEPTH, D_FF, D), D_FF ** -0.5),
        "g_final": 1.0 + nrm(ks[20], (D,), 0.05),
    }


def reference(x, c, ctx, c_ctx, w_mod, b_mod, g_mix, g_ffn, a_w_in, a_b_gate, a_head_gain,
              a_w_out, b_w_in, b_w_conv, b_w_out, f_w_up, f_w_conv, f_b_conv, f_w_down, g_final):
    bn, t, d = x.shape
    rows = t // GRID_W
    lat_row_conv = lambda a, w: conv3(a.reshape(bn, rows, GRID_W, a.shape[-1]), w, 2).reshape(a.shape)
    lat_col_conv = lambda a, w: conv3(a.reshape(bn, rows, GRID_W, a.shape[-1]), w, 1).reshape(a.shape)
    seq_conv = lambda a, w: conv3(a, w, 1)
    rec_layers = [i for i in range(DEPTH) if i % N_MIXERS == 0]
    last_rec = max(rec_layers) if rec_layers else -1

    for i in range(DEPTH):
        j = i // N_MIXERS
        ctx_read = i <= last_rec
        ctx_live = i < last_rec
        mod = jax.nn.silu(c) @ w_mod[i] + b_mod[i]
        sh1, sc1, ga1, sh2, sc2, ga2 = [m[:, None, :] for m in jnp.split(mod, 6, axis=-1)]
        if ctx_read:
            mod_c = jax.nn.silu(c_ctx) @ w_mod[i] + b_mod[i]
            csh1, csc1, cga1, csh2, csc2, cga2 = jnp.split(mod_c, 6, axis=-1)
            hc = modulate(ctx, g_mix[i], csh1, csc1)
        hx = modulate(x, g_mix[i], sh1, sc1)
        if i % N_MIXERS == 0:
            y, yc = mlstm_mixer(hx, hc, a_w_in[j], a_b_gate[j], a_head_gain[j], a_w_out[j], ctx_live)
        else:
            y = shortconv_mixer(hx, b_w_in[j], b_w_conv[j], b_w_out[j], lat_row_conv)
            yc = shortconv_mixer(hc, b_w_in[j], b_w_conv[j], b_w_out[j], seq_conv) if ctx_live else None
        x = x + ga1 * y
        hx = modulate(x, g_ffn[i], sh2, sc2)
        x = x + ga2 * conv_glu(hx, f_w_up[i], f_w_conv[i], f_b_conv[i], f_w_down[i], lat_col_conv)
        if ctx_live:
            ctx = ctx + cga1 * yc
            hc = modulate(ctx, g_ffn[i], csh2, csc2)
            ctx = ctx + cga2 * conv_glu(hc, f_w_up[i], f_w_conv[i], f_b_conv[i], f_w_down[i], seq_conv)

    return rmsnorm(x, g_final)
```

```cpp
#include <hip/hip_runtime.h>
#include <cstdio>
#include <cstdint>
namespace pg8 {
#define PG8_LAS __attribute__((address_space(3)))
typedef unsigned short bf16_t;
typedef short bf16x8 __attribute__((ext_vector_type(8)));
typedef float f32x4 __attribute__((ext_vector_type(4)));
typedef unsigned u32x4 __attribute__((ext_vector_type(4)));
constexpr int BM = 256, BK = 64, HALF = 128, HTB = HALF * BK * 2  , STAGE_BYTES = 8 * HTB, NXCD = 8, WGM = 8;

__host__ __device__ __forceinline__ int lds_byte(int r, int c) { const int st = (r >> 4) * 2 + (c >> 5), rr = r & 15, cc = c & 31, ob = rr * 64 + cc * 2; return st * 1024 + (ob ^ (((ob >> 9) & 1) << 5)); }
__host__ __device__ __forceinline__ void stage_rc(int b, int& R, int& C) { const int st = b / 1024, sb = b % 1024, swz = sb ^ (((sb >> 9) & 1) << 5); R = (st >> 1) * 16 + swz / 64; C = (st & 1) * 32 + (swz % 64) / 2; }
__host__ __device__ __forceinline__ int perm32(int rho) { const int n = rho >> 4, i = rho & 15; return 8 * (i >> 2) + 4 * n + (i & 3); }

struct Unit { int pm, pn; };
struct Gemm { const bf16_t* A; const bf16_t* Bt; int M, N, K; int ld = 0; };

struct StaticOrder {
    int nM, nN, nwg, G, c;
    __host__ __device__ void init(int M, int N, int G_, int c_) { nM = M / BM; nN = N / BM; nwg = nM * nN; G = G_; c = c_; }
    __host__ __device__ bool next(int i, Unit& u) const {
        const long L = (long)i * G + c; if (L >= nwg) return false;
        int wgid = (int)L; { const int q = nwg / NXCD, r = nwg % NXCD, xcd = wgid % NXCD, off = wgid / NXCD; wgid = (xcd < r ? xcd * (q + 1) : r * (q + 1) + (xcd - r) * q) + off; }
        const int nig = WGM * nN, gid = wgid / nig, fm = gid * WGM, gsz = (nM - fm) < WGM ? (nM - fm) : WGM;
        u.pm = fm + ((wgid % nig) % gsz); u.pn = (wgid % nig) / gsz; return true;
    }
    __device__ __forceinline__ void a_ready(const Unit&) const {}
    __device__ __forceinline__ void done(const Unit&) const {}
};

__device__ __forceinline__ unsigned cvt_pk_bf16(float lo, float hi) { unsigned r; asm volatile("v_cvt_pk_bf16_f32 %0, %1, %2" : "=v"(r) : "v"(lo), "v"(hi)); return r; }

struct NatA {
    static __device__ __forceinline__ unsigned voff(int R, int C, int K) { return (unsigned)(R * K + C) * 2u; }
    static __device__ __forceinline__ size_t hstep(int K) { return (size_t)HALF * K * 2; }
    static __device__ __forceinline__ size_t tbase(int pm, int K) { return (size_t)pm * 2 * HALF * K * 2; }
};
template <class Epi, class Sched, bool ALIGN_EPI = false, bool SP2 = false, class AM = NatA>
__device__ __forceinline__ void gemm_phase(PG8_LAS unsigned char* lds, const Gemm g, const Sched& S, const Epi& E) {
    int tid_l = threadIdx.x; asm volatile("" : "+v"(tid_l));
    const int tid = tid_l, wid = __builtin_amdgcn_readfirstlane(tid >> 6), lane = tid & 63, wr = wid >> 2, wc = wid & 3, fr = lane & 15, fq = lane >> 4;
    const int K = g.ld ? g.ld : g.K, nt = g.K / BK;
    unsigned voffA[2], voffB[2];
#pragma unroll
    for (int i = 0; i < 2; ++i) { int R, C; stage_rc(tid * 16 + i * 8192, R, C); const int Rb = Epi::PERM ? ((R & ~31) + perm32(R & 31)) : R;
        voffA[i] = AM::voff(R, C, K); voffB[i] = (unsigned)(Rb * K + C) * 2u; }
    const size_t kstep = (size_t)(BK * 2);
    const size_t hstep = (size_t)HALF * K * 2;
    const size_t hstepA = AM::hstep(K);
    const size_t tstep = 2 * hstep;
    const unsigned ldsw = (unsigned)wid * 1024u;
    const int aoff = lds_byte(wr * 64 + fr, fq * 8), boff = lds_byte(wc * 32 + fr, fq * 8);
#define PG8_SA(b, h) (((b) * 2 + (h)) * HTB)
#define PG8_SB(b, h) ((4 + (b) * 2 + (h)) * HTB)
#define PG8_STAGE(bufoff, gbase, voff) do { _Pragma("unroll") for (int _i = 0; _i < 2; ++_i) \
        __builtin_amdgcn_global_load_lds((const unsigned*)((const char*)(gbase) + (voff)[_i]), (PG8_LAS unsigned*)(lds + (bufoff) + ldsw + _i * 8192), 16, 0, 0); } while (0)
#define PG8_LDA(dst, b, h) do { _Pragma("unroll") for (int m = 0; m < 4; ++m) _Pragma("unroll") for (int k = 0; k < 2; ++k) dst[m][k] = *(const PG8_LAS bf16x8*)(lds + PG8_SA(b, h) + aoff + m * 2048 + k * 1024); } while (0)
#define PG8_LDB(dst, b, h) do { _Pragma("unroll") for (int n = 0; n < 2; ++n) _Pragma("unroll") for (int k = 0; k < 2; ++k) dst[n][k] = *(const PG8_LAS bf16x8*)(lds + PG8_SB(b, h) + boff + n * 2048 + k * 1024); } while (0)
#define PG8_MMA(ai, bj, At, Bt) do { __builtin_amdgcn_s_setprio(1); _Pragma("unroll") for (int m = 0; m < 4; ++m) _Pragma("unroll") for (int n = 0; n < 2; ++n) _Pragma("unroll") for (int k = 0; k < 2; ++k) \
        acc[ai][bj][m][n] = __builtin_amdgcn_mfma_f32_16x16x32_bf16(Bt[n][k], At[m][k], acc[ai][bj][m][n], 0, 0, 0); __builtin_amdgcn_s_setprio(0); } while (0)
#define PG8_WAIT_V(n) asm volatile("s_waitcnt vmcnt(" #n ")" ::: "memory")
#define PG8_WAIT_L(n) asm volatile("s_waitcnt lgkmcnt(" #n ")" ::: "memory")
#define PG8_BAR __builtin_amdgcn_s_barrier()
#define PG8_SCHED __builtin_amdgcn_sched_barrier(0)
    Unit cur, nxt; int ui = 0;
    if (!S.next(0, cur)) return;
    f32x4 acc[2][2][4][2];
#pragma unroll
    for (int a = 0; a < 2; ++a)
#pragma unroll
        for (int b = 0; b < 2; ++b)
#pragma unroll
            for (int m = 0; m < 4; ++m)
#pragma unroll
                for (int n = 0; n < 2; ++n) acc[a][b][m][n] = (f32x4){0.f, 0.f, 0.f, 0.f};
    bf16x8 At[4][2], B0[2][2], B1[2][2];
    const char* cA = (const char*)g.A + AM::tbase(cur.pm, K); const char* cB = (const char*)g.Bt + (size_t)cur.pn * tstep;
    S.a_ready(cur);
    if constexpr (SP2) {
        PG8_STAGE(PG8_SB(0, 0), cB, voffB); PG8_STAGE(PG8_SB(0, 1), cB + hstep, voffB); PG8_STAGE(PG8_SA(0, 0), cA, voffA); PG8_STAGE(PG8_SA(0, 1), cA + hstepA, voffA);
        if (wr == 1) PG8_BAR;
        PG8_WAIT_V(2); PG8_BAR;
        PG8_STAGE(PG8_SB(1, 0), cB + kstep, voffB); PG8_STAGE(PG8_SA(1, 0), cA + kstep, voffA); PG8_STAGE(PG8_SB(1, 1), cB + hstep + kstep, voffB);
        PG8_WAIT_V(6); PG8_BAR;
    } else {
        PG8_STAGE(PG8_SB(0, 0), cB, voffB); PG8_STAGE(PG8_SA(0, 0), cA, voffA); PG8_STAGE(PG8_SB(0, 1), cB + hstep, voffB); PG8_STAGE(PG8_SA(0, 1), cA + hstepA, voffA);
        if (wr == 1) PG8_BAR;
        PG8_WAIT_V(4); PG8_BAR;
        PG8_STAGE(PG8_SB(1, 0), cB + kstep, voffB); PG8_STAGE(PG8_SA(1, 0), cA + kstep, voffA); PG8_STAGE(PG8_SB(1, 1), cB + hstep + kstep, voffB);
        PG8_WAIT_V(6); PG8_BAR;
    }
    for (;;) {
        const bool has_next = S.next(ui + 1, nxt);
        const char* nA = has_next ? (const char*)g.A + AM::tbase(nxt.pm, K) : cA; const char* nB = has_next ? (const char*)g.Bt + (size_t)nxt.pn * tstep : cB;
        for (int t = 0; t < nt; t += 2) {
            const bool last = (t == nt - 2);
            const char* a1 = cA + (size_t)(t + 1) * kstep;
            const char* a2 = last ? nA : cA + (size_t)(t + 2) * kstep; const char* b2 = last ? nB : cB + (size_t)(t + 2) * kstep;
            const char* a3 = a2 + kstep; const char* b3 = b2 + kstep;
            if (last && has_next) S.a_ready(nxt);
            if constexpr (SP2) {
            PG8_LDB(B0, 0, 0); PG8_LDB(B1, 0, 1); PG8_SCHED; PG8_LDA(At, 0, 0); PG8_STAGE(PG8_SA(1, 1), a1 + hstepA, voffA);
            PG8_WAIT_V(8); PG8_WAIT_L(0); PG8_BAR; PG8_MMA(0, 0, At, B0); PG8_MMA(0, 1, At, B1); PG8_BAR; PG8_SCHED;
            PG8_LDA(At, 0, 1); PG8_STAGE(PG8_SB(0, 0), b2, voffB); PG8_STAGE(PG8_SB(0, 1), b2 + hstep, voffB); PG8_STAGE(PG8_SA(0, 0), a2, voffA);
            PG8_WAIT_V(8); PG8_WAIT_L(0); PG8_BAR; PG8_MMA(1, 0, At, B0); PG8_MMA(1, 1, At, B1); PG8_BAR; PG8_SCHED;
            PG8_LDB(B0, 1, 0); PG8_LDB(B1, 1, 1); PG8_SCHED; PG8_LDA(At, 1, 0); PG8_STAGE(PG8_SA(0, 1), a2 + hstepA, voffA);
            PG8_WAIT_V(8); PG8_WAIT_L(0); PG8_BAR; PG8_MMA(0, 0, At, B0); PG8_MMA(0, 1, At, B1); PG8_BAR; PG8_SCHED;
            PG8_LDA(At, 1, 1); PG8_STAGE(PG8_SB(1, 0), b3, voffB); PG8_STAGE(PG8_SB(1, 1), b3 + hstep, voffB); PG8_STAGE(PG8_SA(1, 0), a3, voffA);
            PG8_WAIT_V(8); PG8_WAIT_L(0); PG8_BAR; PG8_MMA(1, 0, At, B0); PG8_MMA(1, 1, At, B1); PG8_BAR; PG8_SCHED;
            } else {
            PG8_LDB(B0, 0, 0); PG8_SCHED; PG8_LDA(At, 0, 0); PG8_STAGE(PG8_SA(1, 1), a1 + hstepA, voffA);
            PG8_WAIT_L(8); PG8_BAR; PG8_WAIT_L(0); PG8_MMA(0, 0, At, B0); PG8_BAR; PG8_SCHED;
            PG8_LDB(B1, 0, 1); PG8_STAGE(PG8_SB(0, 0), b2, voffB);
            PG8_BAR; PG8_WAIT_L(0); PG8_MMA(0, 1, At, B1); PG8_BAR;
            PG8_LDA(At, 0, 1); PG8_STAGE(PG8_SA(0, 0), a2, voffA);
            PG8_BAR; PG8_WAIT_L(0); PG8_MMA(1, 0, At, B0); PG8_BAR; PG8_SCHED;
            PG8_STAGE(PG8_SB(0, 1), b2 + hstep, voffB);
            PG8_WAIT_V(6); PG8_BAR; PG8_MMA(1, 1, At, B1); PG8_BAR;
            PG8_LDB(B0, 1, 0); PG8_SCHED; PG8_LDA(At, 1, 0); PG8_STAGE(PG8_SA(0, 1), a2 + hstepA, voffA);
            PG8_WAIT_L(8); PG8_BAR; PG8_WAIT_L(0); PG8_MMA(0, 0, At, B0); PG8_BAR; PG8_SCHED;
            PG8_LDB(B1, 1, 1); PG8_STAGE(PG8_SB(1, 0), b3, voffB);
            PG8_BAR; PG8_WAIT_L(0); PG8_MMA(0, 1, At, B1); PG8_BAR;
            PG8_LDA(At, 1, 1); PG8_STAGE(PG8_SA(1, 0), a3, voffA);
            PG8_BAR; PG8_WAIT_L(0); PG8_MMA(1, 0, At, B0); PG8_BAR; PG8_SCHED;
            PG8_STAGE(PG8_SB(1, 1), b3 + hstep, voffB);
            PG8_WAIT_V(6); PG8_BAR; PG8_MMA(1, 1, At, B1); PG8_BAR;
            }
        }
        if constexpr (ALIGN_EPI) { if (wr == 0) PG8_BAR; }
        if constexpr (!Epi::AFTER_DRAIN) { E(acc, cur, wr, wc, fr, fq); S.done(cur); }
        if (!has_next) break;
#pragma unroll
        for (int a = 0; a < 2; ++a)
#pragma unroll
            for (int b = 0; b < 2; ++b)
#pragma unroll
                for (int m = 0; m < 4; ++m)
#pragma unroll
                    for (int n = 0; n < 2; ++n) acc[a][b][m][n] = (f32x4){0.f, 0.f, 0.f, 0.f};
        cur = nxt; cA = nA; cB = nB; ++ui;
        if constexpr (ALIGN_EPI) { if (wr == 1) PG8_BAR; }
    }
    PG8_WAIT_V(0);
    if constexpr (!ALIGN_EPI) { if (wr == 0) PG8_BAR; }
    PG8_BAR;
    if constexpr (Epi::AFTER_DRAIN) { E.fused(acc, cur, wr, wc, fr, fq, lds, wid, lane); S.done(cur); }
#undef PG8_SA
#undef PG8_SB
#undef PG8_STAGE
#undef PG8_LDA
#undef PG8_LDB
#undef PG8_MMA
#undef PG8_WAIT_V
#undef PG8_WAIT_L
#undef PG8_BAR
#undef PG8_SCHED
}
}

namespace {
using pg8::bf16_t; using pg8::bf16x8; using pg8::f32x4; using pg8::u32x4; using pg8::Unit; using pg8::Gemm; using pg8::StaticOrder; using pg8::cvt_pk_bf16;
#define GAS __attribute__((address_space(1)))
#define LAS __attribute__((address_space(3)))
typedef unsigned v2u __attribute__((ext_vector_type(2)));
typedef float f32x16 __attribute__((ext_vector_type(16)));

constexpr int D = 1024, NB = 4, SEQ = 8192, TL = NB * SEQ  , CTXL = 256, TC = NB * CTXL  , TT = TL + TC  ;
constexpr int DEPTH = 4, NH = 4, DK = 128, DV = 256, CHUNK = 64, DFF = 2816, APROJ = 3088, MODW = 6 * D;
constexpr float EPS = 1e-6f;
constexpr int NWAVES = 8, NTHR = 512;

constexpr size_t MiB = 1u << 20;
constexpr size_t WS_CTL = 0, CTL_ZERO_BYTES = 2 * MiB;
constexpr int CW_BAR = 4096;
constexpr size_t WS_MOD = 1 * MiB;
constexpr size_t WS_GATES = 2 * MiB;
constexpr size_t WS_GM = 5 * MiB;
constexpr size_t WS_NST = 5 * MiB + 65536;
constexpr size_t WS_CTXRES = 7 * MiB;
constexpr size_t WS_W = 11 * MiB;
constexpr size_t W_AING = 12 * MiB;
constexpr size_t W_AIN = 0, W_AOUT = 16 * MiB, W_BIN = 20 * MiB, W_BOUT = 32 * MiB, W_UP = 36 * MiB, W_DN = 80 * MiB;
constexpr size_t WS_HX = 113 * MiB;
constexpr size_t WS_BIG = 179 * MiB;
constexpr size_t BIG_Q = 0, BIG_O = 33 * MiB, BIG_K = 99 * MiB, BIG_VT = 132 * MiB, BIG_UC = 198 * MiB;
constexpr size_t BIG_CU = 0, BIG_Z = 66 * MiB, BIG_PC = 132 * MiB;
constexpr size_t BIG_XF = 198 * MiB;
constexpr size_t BIG_CPART = 282 * MiB;
constexpr size_t BIG_A = 0, BIG_GV = 182 * MiB, BIG_GVC = 270 * MiB;
constexpr size_t WS_MODP = WS_BIG;
constexpr size_t WS_END = 509 * MiB;

constexpr int LDS_BYTES = 147456;
constexpr int MISC_OFF = LDS_BYTES - 256;

__device__ __forceinline__ float bf2f(unsigned short b) { return __uint_as_float(((unsigned)b) << 16); }
__device__ __forceinline__ float bflo(unsigned w) { return __uint_as_float(w << 16); }
__device__ __forceinline__ float bfhi(unsigned w) { return __uint_as_float(w & 0xffff0000u); }
__device__ __forceinline__ unsigned f2bf(float f) { unsigned u = __float_as_uint(f); return (u + 0x7fffu + ((u >> 16) & 1u)) >> 16; }
__device__ __forceinline__ float bfround(float f) { return __uint_as_float(f2bf(f) << 16); }
typedef __bf16 bf16v2_t __attribute__((ext_vector_type(2)));
__device__ __forceinline__ unsigned pk2(float lo, float hi) { bf16v2_t t; t.x = (__bf16)lo; t.y = (__bf16)hi; return __builtin_bit_cast(unsigned, t); }
__device__ __forceinline__ float wave_sum(float v) {
#pragma unroll
    for (int o = 1; o < 64; o <<= 1) v += __shfl_xor(v, o);
    return v;
}
__device__ __forceinline__ float wave_max(float v) {
#pragma unroll
    for (int o = 1; o < 64; o <<= 1) v = fmaxf(v, __shfl_xor(v, o));
    return v;
}
__device__ __forceinline__ float prefix_sum64(float x, int lane) {
#pragma unroll
    for (int o = 1; o < 64; o <<= 1) { const float y = __shfl_up(x, o); if (lane >= o) x += y; }
    return x;
}
__device__ __forceinline__ float prefix_max64(float x, int lane) {
#pragma unroll
    for (int o = 1; o < 64; o <<= 1) { const float y = __shfl_up(x, o); if (lane >= o) x = fmaxf(x, y); }
    return x;
}
__device__ __forceinline__ void lds_add(LAS float* p, float v) { (void)__hip_atomic_fetch_add(p, v, __ATOMIC_RELAXED, __HIP_MEMORY_SCOPE_WORKGROUP); }
__device__ __forceinline__ float sigmoidf_(float x) { return __builtin_amdgcn_rcpf(1.0f + __expf(-x)); }
__device__ __forceinline__ float siluf_(float x) { return x * __builtin_amdgcn_rcpf(1.0f + __expf(-x)); }
__device__ __forceinline__ float logsigmoidf_(float x) { const float y = __expf(-fabsf(x)); const float l = y < 0.0625f ? y * (1.0f - y * (0.5f - y * (0.33333334f - y * (0.25f - 0.2f * y)))) : __logf(1.0f + y); return fminf(x, 0.f) - l; }

__device__ __forceinline__ void unpack8(const u32x4 w, float (&f)[8]) { f[0] = bflo(w.x); f[1] = bfhi(w.x); f[2] = bflo(w.y); f[3] = bfhi(w.y); f[4] = bflo(w.z); f[5] = bfhi(w.z); f[6] = bflo(w.w); f[7] = bfhi(w.w); }

#define XB_TMO      128
#define XB_XCNT(j)  (256  + 64 * (j))
#define XB_XSUB(j)  (1280 + 64 * (j))
#define XB_XGEN(j)  (2304 + 64 * (j))
#define XB_TOP      3328
#define XB_TOPGEN   3392
#define XCD_BAR_WORDS 3456
#define XB_SPIN_CAP (1u << 18)
__device__ __forceinline__ unsigned xb_ld(unsigned* p)              { return __hip_atomic_load(p, __ATOMIC_RELAXED, __HIP_MEMORY_SCOPE_AGENT); }
__device__ __forceinline__ unsigned xb_add(unsigned* p, unsigned v) { return __hip_atomic_fetch_add(p, v, __ATOMIC_RELAXED, __HIP_MEMORY_SCOPE_AGENT); }
__device__ __forceinline__ unsigned xb_xcc_id() { return (unsigned)__builtin_amdgcn_s_getreg((3 << 11) | 20) & 0xFu; }
#define XB_SPIN(cond, bar) do { unsigned _sp = 0; while (cond) { __builtin_amdgcn_s_sleep(1); \
    if ((++_sp & 255u) == 0u) { if (xb_ld(&(bar)[XB_TMO])) break; if (_sp > XB_SPIN_CAP) { atomicAdd(&(bar)[XB_TMO], 1u); break; } } } } while (0)
struct XcdBarrier { unsigned* bar; unsigned x; volatile LAS unsigned* st; };
__device__ __forceinline__ XcdBarrier xcd_barrier_post(unsigned* bar, volatile LAS unsigned* st) {
    XcdBarrier b; b.bar = bar; b.x = xb_xcc_id(); b.st = st;
    if (threadIdx.x == 0) (void)xb_add(&bar[XB_XCNT(b.x)], 1u);
    return b;
}
__device__ __forceinline__ void xcd_barrier_complete(unsigned* bar, unsigned x, unsigned& nloc, unsigned& nx) {
    const unsigned G = gridDim.x * gridDim.y * gridDim.z;
    unsigned sum, cnt, mine, sp = 0u;
    for (;;) {
        sum = 0u; cnt = 0u; mine = 0u;
#pragma unroll
        for (unsigned j = 0; j < 16; ++j) { const unsigned c = xb_ld(&bar[XB_XCNT(j)]); sum += c; cnt += (c > 0u) ? 1u : 0u; mine = (j == x) ? c : mine; }
        if (sum == G) break;
        __builtin_amdgcn_s_sleep(1);
        if ((++sp & 255u) == 0u) { if (xb_ld(&bar[XB_TMO])) break; if (sp > XB_SPIN_CAP) { atomicAdd(&bar[XB_TMO], 1u); break; } }
    }
    nloc = mine > 0u ? mine : 1u; nx = cnt > 0u ? cnt : 1u;
}
__device__ __forceinline__ void xcd_barrier(const XcdBarrier& b) {
    asm volatile("s_waitcnt vmcnt(0)" ::: "memory");
    __syncthreads();
    if (threadIdx.x == 0) {
        unsigned* bar = b.bar;
        __builtin_amdgcn_s_waitcnt(0);
        unsigned nloc = b.st[0], nx = b.st[1];
        if (nloc == 0u) { xcd_barrier_complete(bar, b.x, nloc, nx); b.st[0] = nloc; b.st[1] = nx; }
        const unsigned old = xb_add(&bar[XB_XSUB(b.x)], 1u);
        const unsigned gen = old / nloc;
        if (old + 1u == (gen + 1u) * nloc) {
            __builtin_amdgcn_fence(__ATOMIC_RELEASE, "agent");
            asm volatile("s_waitcnt vmcnt(0)" ::: "memory");
            const unsigned og = xb_add(&bar[XB_TOP], 1u);
            const unsigned tg = og / nx;
            if (og + 1u == (tg + 1u) * nx) xb_add(&bar[XB_TOPGEN], 1u);
            else XB_SPIN(xb_ld(&bar[XB_TOPGEN]) == tg, bar);
            __builtin_amdgcn_fence(__ATOMIC_ACQUIRE, "agent");
            xb_add(&bar[XB_XGEN(b.x)], 1u);
            asm volatile("s_waitcnt vmcnt(0)" ::: "memory");
        } else {
            XB_SPIN(xb_ld(&bar[XB_XGEN(b.x)]) == gen, bar);
            __builtin_amdgcn_fence(__ATOMIC_ACQUIRE, "agent");
            asm volatile("s_waitcnt vmcnt(0)" ::: "memory");
        }
    }
    __syncthreads();
}

struct EpiStoreBf16 {
    static constexpr bool PERM = true, AFTER_DRAIN = false;
    bf16_t* O; int ldc; int split_cols; size_t split_stride;
    __device__ __forceinline__ void operator()(const f32x4 (&acc)[2][2][4][2], const Unit& u, int wr, int wc, int fr, int fq) const {
        const int row0 = u.pm * 256 + wr * 64 + fr; int colt = u.pn * 256; bf16_t* base = O;
        if (split_cols) { const int t = colt / split_cols; base += (size_t)t * split_stride; colt -= t * split_cols; }
        const int col0 = colt + wc * 32 + 8 * fq;
#pragma unroll
        for (int ai = 0; ai < 2; ++ai)
#pragma unroll
            for (int m = 0; m < 4; ++m) { bf16_t* rowp = base + (size_t)(row0 + ai * 128 + m * 16) * ldc + col0;
#pragma unroll
                for (int bj = 0; bj < 2; ++bj) { const f32x4 v0 = acc[ai][bj][m][0], v1 = acc[ai][bj][m][1];
                    u32x4 w; w.x = cvt_pk_bf16(v0[0], v0[1]); w.y = cvt_pk_bf16(v0[2], v0[3]); w.z = cvt_pk_bf16(v1[0], v1[1]); w.w = cvt_pk_bf16(v1[2], v1[3]);
                    *(u32x4*)(rowp + bj * 128) = w; } }
    }
};
struct EpiQOK {
    static constexpr bool PERM = true, AFTER_DRAIN = false;
    bf16_t *Q, *O, *K; int row_off;
    __device__ __forceinline__ void operator()(const f32x4 (&acc)[2][2][4][2], const Unit& u, int wr, int wc, int fr, int fq) const {
        bf16_t* base; int ldc, colt;
        if (u.pn < 2) { base = Q; ldc = 512; colt = u.pn * 256; } else if (u.pn < 6) { base = O; ldc = 1024; colt = (u.pn - 2) * 256; } else { base = K; ldc = 512; colt = (u.pn - 6) * 256; }
        const int row0 = row_off + u.pm * 256 + wr * 64 + fr, col0 = colt + wc * 32 + 8 * fq;
#pragma unroll
        for (int ai = 0; ai < 2; ++ai)
#pragma unroll
            for (int m = 0; m < 4; ++m) { bf16_t* rowp = base + (size_t)(row0 + ai * 128 + m * 16) * ldc + col0;
#pragma unroll
                for (int bj = 0; bj < 2; ++bj) { const f32x4 v0 = acc[ai][bj][m][0], v1 = acc[ai][bj][m][1];
                    u32x4 w; w.x = cvt_pk_bf16(v0[0], v0[1]); w.y = cvt_pk_bf16(v0[2], v0[3]); w.z = cvt_pk_bf16(v1[0], v1[1]); w.w = cvt_pk_bf16(v1[2], v1[3]);
                    *(u32x4*)(rowp + bj * 128) = w; } }
    }
};
struct ColStripA {
    static __device__ __forceinline__ unsigned voff(int R, int C, int K) { return (unsigned)(((8 * (R & 15) + ((R >> 4) & 3)) * 64 + (R >> 6)) * K + C) * 2u; }
    static __device__ __forceinline__ size_t hstep(int K) { return (size_t)256 * K * 2; }
    static __device__ __forceinline__ size_t tbase(int pm, int K) { return (size_t)((pm >> 5) * SEQ + 2 * (pm & 31)) * K * 2; }
};
__device__ __forceinline__ f32x4 dpp_prev(const f32x4 x) { f32x4 r;
#pragma unroll
    for (int j = 0; j < 4; ++j) r[j] = __int_as_float(__builtin_amdgcn_update_dpp(0, __float_as_int(x[j]), 0x111, 0xf, 0xf, true));
    return r; }
__device__ __forceinline__ f32x4 dpp_next(const f32x4 x) { f32x4 r;
#pragma unroll
    for (int j = 0; j < 4; ++j) r[j] = __int_as_float(__builtin_amdgcn_update_dpp(0, __float_as_int(x[j]), 0x101, 0xf, 0xf, true));
    return r; }
struct EpiConvGLU {
    static constexpr bool PERM = true, AFTER_DRAIN = false;
    bf16_t* Aout; const float* wconv  ; const float* bconv  ;
    __device__ __forceinline__ void operator()(const f32x4 (&acc)[2][2][4][2], const Unit& u, int wr, int wc, int fr, int fq) const {
        const int ch0 = u.pn * 128 + wc * 32 + 8 * fq;
        const size_t tok0 = (size_t)(u.pm >> 5) * SEQ + 2 * (u.pm & 31) + wr;
        f32x4 w0[2], w1[2], w2[2], bb[2];
#pragma unroll
        for (int n = 0; n < 2; ++n) { w0[n] = *(const f32x4*)(wconv + ch0 + 4 * n); w1[n] = *(const f32x4*)(wconv + DFF + ch0 + 4 * n); w2[n] = *(const f32x4*)(wconv + 2 * DFF + ch0 + 4 * n); bb[n] = *(const f32x4*)(bconv + ch0 + 4 * n); }
#pragma unroll
        for (int s = 0; s < 8; ++s) {
            const int ai = s >> 2, m = s & 3;
            u32x4 w;
#pragma unroll
            for (int n = 0; n < 2; ++n) {
                const f32x4 gp = s > 0 ? acc[(s - 1) >> 2][0][(s - 1) & 3][n] : dpp_prev(acc[1][0][3][n]);
                const f32x4 gn = s < 7 ? acc[(s + 1) >> 2][0][(s + 1) & 3][n] : dpp_next(acc[0][0][0][n]);
                const f32x4 t = w0[n] * gp + w1[n] * acc[ai][0][m][n] + w2[n] * gn + bb[n];
                f32x4 o;
#pragma unroll
                for (int j = 0; j < 4; ++j) o[j] = siluf_(t[j]) * acc[ai][1][m][n][j];
                if (n == 0) { w.x = pk2(o[0], o[1]); w.y = pk2(o[2], o[3]); } else { w.z = pk2(o[0], o[1]); w.w = pk2(o[2], o[3]); }
            }
            *(u32x4*)(Aout + (tok0 + (size_t)(8 * fr + s) * 64) * DFF + ch0) = w;
        }
    }
};
struct SeqStripA {
    static __device__ __forceinline__ unsigned voff(int R, int C, int K) { return (unsigned)((128 * (R >> 6) + 8 * (R & 15) + ((R >> 4) & 3)) * K + C) * 2u; }
    static __device__ __forceinline__ size_t hstep(int K) { return (size_t)4 * K * 2; }
    static __device__ __forceinline__ size_t tbase(int pm, int K) { return (size_t)pm * 256 * K * 2; }
};
struct EpiConvU {
    static constexpr bool PERM = true, AFTER_DRAIN = false;
    bf16_t* CU; const float* wconv  ;
    __device__ __forceinline__ void operator()(const f32x4 (&acc)[2][2][4][2], const Unit& u, int wr, int wc, int fr, int fq) const {
        const int ch0 = u.pn * 128 + wc * 32 + 8 * fq;
        const size_t tok0 = (size_t)u.pm * 256 + 128 * wr + 8 * fr;
        const bool first = (fr & 7) == 0, last = (fr & 7) == 7;
        f32x4 w0[2], w1[2], w2[2];
#pragma unroll
        for (int n = 0; n < 2; ++n) { w0[n] = *(const f32x4*)(wconv + ch0 + 4 * n); w1[n] = *(const f32x4*)(wconv + D + ch0 + 4 * n); w2[n] = *(const f32x4*)(wconv + 2 * D + ch0 + 4 * n); }
        f32x4 pv[2], nx[2];
#pragma unroll
        for (int n = 0; n < 2; ++n) { pv[n] = dpp_prev(acc[1][0][3][n] * acc[1][1][3][n]); nx[n] = dpp_next(acc[0][0][0][n] * acc[0][1][0][n]);
            if (first) pv[n] = (f32x4){0.f, 0.f, 0.f, 0.f}; if (last) nx[n] = (f32x4){0.f, 0.f, 0.f, 0.f}; }
#pragma unroll
        for (int s = 0; s < 8; ++s) {
            u32x4 w;
#pragma unroll
            for (int n = 0; n < 2; ++n) {
                const f32x4 up = s > 0 ? acc[(s - 1) >> 2][0][(s - 1) & 3][n] * acc[(s - 1) >> 2][1][(s - 1) & 3][n] : pv[n];
                const f32x4 un = s < 7 ? acc[(s + 1) >> 2][0][(s + 1) & 3][n] * acc[(s + 1) >> 2][1][(s + 1) & 3][n] : nx[n];
                const f32x4 o = w0[n] * up + w1[n] * (acc[s >> 2][0][s & 3][n] * acc[s >> 2][1][s & 3][n]) + w2[n] * un;
                if (n == 0) { w.x = pk2(o[0], o[1]); w.y = pk2(o[2], o[3]); } else { w.z = pk2(o[0], o[1]); w.w = pk2(o[2], o[3]); }
            }
            *(u32x4*)(CU + (tok0 + s) * D + ch0) = w;
        }
    }
};
struct EpiMulZ {
    static constexpr bool PERM = true, AFTER_DRAIN = false;
    const bf16_t* CU; bf16_t* Z;
    __device__ __forceinline__ void operator()(const f32x4 (&acc)[2][2][4][2], const Unit& u, int wr, int wc, int fr, int fq) const {
        const int row0 = u.pm * 256 + wr * 64 + fr, col0 = u.pn * 256 + wc * 32 + 8 * fq;
        u32x4 cur[2], nxt[2];
#pragma unroll
        for (int bj = 0; bj < 2; ++bj) cur[bj] = *(const u32x4*)(CU + (size_t)row0 * D + col0 + bj * 128);
#pragma unroll
        for (int g = 0; g < 8; ++g) { const int ai = g >> 2, m = g & 3; const size_t off = (size_t)(row0 + ai * 128 + m * 16) * D + col0;
            if (g < 7) { const size_t offn = (size_t)(row0 + ((g + 1) >> 2) * 128 + ((g + 1) & 3) * 16) * D + col0;
#pragma unroll
                for (int bj = 0; bj < 2; ++bj) nxt[bj] = *(const u32x4*)(CU + offn + bj * 128); }
#pragma unroll
            for (int bj = 0; bj < 2; ++bj) { float c[8]; unpack8(cur[bj], c); const f32x4 v0 = acc[ai][bj][m][0], v1 = acc[ai][bj][m][1];
                u32x4 w; w.x = pk2(v0[0] * c[0], v0[1] * c[1]); w.y = pk2(v0[2] * c[2], v0[3] * c[3]); w.z = pk2(v1[0] * c[4], v1[1] * c[5]); w.w = pk2(v1[2] * c[6], v1[3] * c[7]);
                *(u32x4*)(Z + off + bj * 128) = w; cur[bj] = nxt[bj]; }
        }
    }
};
template <bool BASEF32, bool OUTBF> struct EpiResidual {
    static constexpr bool PERM = true, AFTER_DRAIN = false;
    const void* base; void* out; const float* gate0; int gdiv;
    __device__ __forceinline__ void ldb(size_t off, f32x4 (&d)[2][2]) const {
        if (BASEF32) {
#pragma unroll
            for (int bj = 0; bj < 2; ++bj)
#pragma unroll
                for (int n = 0; n < 2; ++n) d[bj][n] = *(const f32x4*)((const float*)base + off + bj * 128 + n * 4);
        } else {
#pragma unroll
            for (int bj = 0; bj < 2; ++bj) { const u32x4 w = *(const u32x4*)((const bf16_t*)base + off + bj * 128);
                d[bj][0] = (f32x4){bflo(w.x), bfhi(w.x), bflo(w.y), bfhi(w.y)}; d[bj][1] = (f32x4){bflo(w.z), bfhi(w.z), bflo(w.w), bfhi(w.w)}; }
        }
    }
    __device__ __forceinline__ void operator()(const f32x4 (&acc)[2][2][4][2], const Unit& u, int wr, int wc, int fr, int fq) const {
        const int row0 = u.pm * 256 + wr * 64 + fr, col0 = u.pn * 256 + wc * 32 + 8 * fq;
        const float* gp = gate0 + (size_t)(u.pm / gdiv) * MODW + col0;
        f32x4 gv[2][2], cur[2][2], nxt[2][2];
#pragma unroll
        for (int bj = 0; bj < 2; ++bj)
#pragma unroll
            for (int n = 0; n < 2; ++n) gv[bj][n] = *(const f32x4*)(gp + bj * 128 + n * 4);
        ldb((size_t)row0 * D + col0, cur);
#pragma unroll
        for (int g = 0; g < 8; ++g) { const int ai = g >> 2, m = g & 3; const size_t off = (size_t)(row0 + ai * 128 + m * 16) * D + col0;
            if (g < 7) ldb((size_t)(row0 + ((g + 1) >> 2) * 128 + ((g + 1) & 3) * 16) * D + col0, nxt);
#pragma unroll
            for (int bj = 0; bj < 2; ++bj) { f32x4 x[2];
#pragma unroll
                for (int n = 0; n < 2; ++n) { x[n] = cur[bj][n] + gv[bj][n] * acc[ai][bj][m][n]; cur[bj][n] = nxt[bj][n]; }
                if (OUTBF) { u32x4 w; w.x = pk2(x[0][0], x[0][1]); w.y = pk2(x[0][2], x[0][3]); w.z = pk2(x[1][0], x[1][1]); w.w = pk2(x[1][2], x[1][3]); *(u32x4*)((bf16_t*)out + off + bj * 128) = w; }
                else { *(f32x4*)((float*)out + off + bj * 128) = x[0]; *(f32x4*)((float*)out + off + bj * 128 + 4) = x[1]; } }
        }
    }
};

template <class Epi, class AM = pg8::NatA>
__device__ __forceinline__ void run_gemm(LAS unsigned char* lds, const bf16_t* A, const bf16_t* Bt, int M, int N, int K, const Epi& E, int boff = 0) {
    Gemm g{A, Bt, M, N, K}; StaticOrder S; const int G = (int)gridDim.x; S.init(M, N, G, ((int)blockIdx.x + G - boff) % G);
    pg8::gemm_phase<Epi, StaticOrder, true, true, AM>(lds, g, S, E);
}

template <class Epi>
__device__ __forceinline__ void run_gemm_slice(LAS unsigned char* lds, const bf16_t* A, const bf16_t* Bt, int M, int N, int k0, int Ks, int ld, int boff, const Epi& E) {
    Gemm g{A + k0, Bt + k0, M, N, Ks, ld}; StaticOrder S; const int G = (int)gridDim.x; S.init(M, N, G, ((int)blockIdx.x + G - boff) % G);
    pg8::gemm_phase<Epi, StaticOrder, true, true>(lds, g, S, E);
}
struct EpiPartF32 {
    static constexpr bool PERM = false, AFTER_DRAIN = false;
    float* Pout;
    __device__ __forceinline__ void operator()(const f32x4 (&acc)[2][2][4][2], const Unit& u, int wr, int wc, int fr, int fq) const {
        const int row0 = u.pm * 256 + wr * 64 + fr, col0 = u.pn * 256 + wc * 32 + 4 * fq;
#pragma unroll
        for (int ai = 0; ai < 2; ++ai)
#pragma unroll
            for (int m = 0; m < 4; ++m) { float* rp = Pout + (size_t)(row0 + ai * 128 + m * 16) * D + col0;
#pragma unroll
                for (int bj = 0; bj < 2; ++bj)
#pragma unroll
                    for (int n = 0; n < 2; ++n) *(f32x4*)(rp + bj * 128 + n * 16) = acc[ai][bj][m][n]; }
    }
};
struct EpiVT {
    static constexpr bool PERM = true, AFTER_DRAIN = false;
    bf16_t* VT; int tok0;
    __device__ __forceinline__ void operator()(const f32x4 (&acc)[2][2][4][2], const Unit& u, int wr, int wc, int fr, int fq) const {
        const int f0 = u.pm * 256 + wr * 64 + fr, r0 = tok0 + u.pn * 256 + wc * 32 + 8 * fq;
#pragma unroll
        for (int ai = 0; ai < 2; ++ai)
#pragma unroll
            for (int m = 0; m < 4; ++m) { const int f = f0 + ai * 128 + m * 16, h = f >> 8, vb = (f & 255) >> 5, vl = f & 31;
#pragma unroll
                for (int bj = 0; bj < 2; ++bj) { const int r = r0 + bj * 128, tb = r >> 7, ks = (r & 127) >> 4, hh = (r >> 3) & 1;
                    const f32x4 v0 = acc[ai][bj][m][0], v1 = acc[ai][bj][m][1];
                    u32x4 w; w.x = cvt_pk_bf16(v0[0], v0[1]); w.y = cvt_pk_bf16(v0[2], v0[3]); w.z = cvt_pk_bf16(v1[0], v1[1]); w.w = cvt_pk_bf16(v1[2], v1[3]);
                    *(u32x4*)(VT + ((size_t)((((tb * 4 + h) * 8 + vb) * 8 + ks) * 2 + hh) * 32 + vl) * 8) = w; } }
    }
};
struct EpiGates {
    static constexpr bool PERM = false, AFTER_DRAIN = false;
    float* GT; const float* bgate; int row0;
    __device__ __forceinline__ void operator()(const f32x4 (&acc)[2][2][4][2], const Unit& u, int wr, int wc, int fr, int fq) const {
        if (wc != 0) return;
        const int r0 = row0 + u.pm * 256 + wr * 64 + fr;
        const f32x4 bg = *(const f32x4*)(bgate + 4 * fq);
#pragma unroll
        for (int ai = 0; ai < 2; ++ai)
#pragma unroll
            for (int m = 0; m < 4; ++m) { const int row = r0 + ai * 128 + m * 16; const f32x4 a = acc[ai][0][m][0] + acc[ai][0][m][1] + bg;
#pragma unroll
                for (int j = 0; j < 4; ++j) GT[(size_t)(4 * fq + j) * TT + row] = fq < 2 ? a[j] : logsigmoidf_(a[j]); }
    }
};

__device__ __forceinline__ void transpose_item(const float* W, int ld, int K, int k0, int n0src, bf16_t* WT, int row0dst, float scale, LAS float* scr, int lane) {
#pragma unroll 8
    for (int i = 0; i < 32; ++i) { const int kk = 2 * i + (lane >> 5); scr[kk * 33 + (lane & 31)] = W[(size_t)(k0 + kk) * ld + n0src + (lane & 31)] * scale; }
    asm volatile("s_waitcnt lgkmcnt(0)" ::: "memory");
    const int c = lane & 7;
#pragma unroll
    for (int j = 0; j < 4; ++j) { const int n = (lane >> 3) + 8 * j; const LAS float* s = scr + (8 * c) * 33 + n;
        u32x4 o; o.x = pk2(s[0 * 33], s[1 * 33]); o.y = pk2(s[2 * 33], s[3 * 33]); o.z = pk2(s[4 * 33], s[5 * 33]); o.w = pk2(s[6 * 33], s[7 * 33]);
        *(u32x4*)(WT + (size_t)(row0dst + n) * K + k0 + 8 * c) = o; }
    asm volatile("s_waitcnt lgkmcnt(0)" ::: "memory");
}
struct Ptrs {
    const float *x, *c, *ctx, *c_ctx, *w_mod, *b_mod, *g_mix, *g_ffn, *a_w_in, *a_b_gate, *a_head_gain, *a_w_out, *b_w_in, *b_w_conv, *b_w_out, *f_w_up, *f_w_conv, *f_b_conv, *f_w_down, *g_final;
    float* out; unsigned char* ws;
};
__device__ __forceinline__ void p0_convert(const Ptrs& P, LAS unsigned char* lds, int wave, int lane) {
    LAS float* scr = (LAS float*)(lds + wave * 16384);
    const int gw = blockIdx.x * NWAVES + wave, NGW = gridDim.x * NWAVES;
    constexpr int I_AIN = 16 * 96, I_AOUT = 16 * 32, I_BIN = 16 * 96, I_BOUT = 16 * 32, I_UP = 16 * 176, I_DN = 44 * 32;
    constexpr int S0 = 2 * I_AIN, S1 = S0 + 2 * I_AOUT, S2 = S1 + 2 * I_BIN, S3 = S2 + 2 * I_BOUT, S4 = S3 + 4 * I_UP, S5 = S4 + 4 * I_DN;
    bf16_t* WB = (bf16_t*)(P.ws + WS_W);
    for (int it = gw; it < S5; it += NGW) {
        if (it < S0) { const int j = it / I_AIN, r = it % I_AIN, kb = r / 96, ng = r % 96;
            const int drow = ng < 16 ? 32 * ng : ng < 32 ? 1536 + 32 * (ng - 16) : ng < 64 ? 2048 + 32 * (ng - 32) : 512 + 32 * (ng - 64);
            transpose_item(P.a_w_in + (size_t)j * D * APROJ, APROJ, D, 64 * kb, 32 * ng, WB + (W_AIN / 2) + (size_t)j * 3072 * D, drow, (ng >= 16 && ng < 32) ? 0.08838834764831845f : 1.0f, scr, lane);
        } else if (it < S1) { const int q = it - S0, j = q / I_AOUT, r = q % I_AOUT, kb = r / 32, ng = r % 32;
            transpose_item(P.a_w_out + (size_t)j * D * D, D, D, 64 * kb, 32 * ng, WB + (W_AOUT / 2) + (size_t)j * D * D, 32 * ng, 1.0f, scr, lane);
        } else if (it < S2) { const int q = it - S1, j = q / I_BIN, r = q % I_BIN, kb = r / 96, ng = r % 96;
            const int c0 = 32 * (ng & 31), drow = ng < 32 ? 2048 + c0 : 256 * (c0 >> 7) + (c0 & 127) + (ng < 64 ? 0 : 128);
            transpose_item(P.b_w_in + (size_t)j * D * 3 * D, 3 * D, D, 64 * kb, 32 * ng, WB + (W_BIN / 2) + (size_t)j * 3 * D * D, drow, 1.0f, scr, lane);
        } else if (it < S3) { const int q = it - S2, j = q / I_BOUT, r = q % I_BOUT, kb = r / 32, ng = r % 32;
            transpose_item(P.b_w_out + (size_t)j * D * D, D, D, 64 * kb, 32 * ng, WB + (W_BOUT / 2) + (size_t)j * D * D, 32 * ng, 1.0f, scr, lane);
        } else if (it < S4) { const int q = it - S3, i = q / I_UP, r = q % I_UP, kb = r / 176, ng = r % 176;
            const int c0 = 32 * (ng < 88 ? ng : ng - 88), drow = 256 * (c0 >> 7) + (c0 & 127) + (ng < 88 ? 0 : 128);
            transpose_item(P.f_w_up + (size_t)i * D * 2 * DFF, 2 * DFF, D, 64 * kb, 32 * ng, WB + (W_UP / 2) + (size_t)i * 2 * DFF * D, drow, 1.0f, scr, lane);
        } else { const int q = it - S4, i = q / I_DN, r = q % I_DN, kb = r / 32, ng = r % 32;
            transpose_item(P.f_w_down + (size_t)i * DFF * D, D, DFF, 64 * kb, 32 * ng, WB + (W_DN / 2) + (size_t)i * D * DFF, 32 * ng, 1.0f, scr, lane);
        }
    }
}
__device__ __forceinline__ void p0_mod(const Ptrs& P, LAS unsigned char* lds, int tid) {
    LAS float* s = (LAS float*)lds;
    for (int i = tid; i < 5 * D; i += NTHR) { const int b = i >> 10, k = i & 1023; const float v = b < 4 ? P.c[b * D + k] : P.c_ctx[k]; s[i] = v / (1.0f + __expf(-v)); }
    __syncthreads();
    float* MODP = (float*)(P.ws + WS_MODP);
    for (int u = blockIdx.x; u < DEPTH * 16 * 12; u += gridDim.x) {
        const int i = u / 192, r = u % 192, ks = r / 12, nb = r % 12, n = nb * 512 + tid;
        const float* w = P.w_mod + ((size_t)i * D + 64 * ks) * MODW + n;
        float a0 = 0.f, a1 = 0.f, a2 = 0.f, a3 = 0.f, a4 = 0.f;
#pragma unroll 8
        for (int k = 0; k < 64; ++k) { const float wv = w[(size_t)k * MODW]; const int kk = 64 * ks + k;
            a0 += s[kk] * wv; a1 += s[D + kk] * wv; a2 += s[2 * D + kk] * wv; a3 += s[3 * D + kk] * wv; a4 += s[4 * D + kk] * wv; }
        float* o = MODP + ((size_t)ks * DEPTH + i) * 5 * MODW + n;
        o[0] = a0; o[MODW] = a1; o[2 * MODW] = a2; o[3 * MODW] = a3; o[4 * MODW] = a4;
    }
}
__device__ __forceinline__ void mod_reduce(const Ptrs& P, int tid) {
    const float* MODP = (const float*)(P.ws + WS_MODP); float* MOD = (float*)(P.ws + WS_MOD);
    for (int e = blockIdx.x * NTHR + tid; e < DEPTH * 5 * MODW; e += gridDim.x * NTHR) {
        const int i = e / (5 * MODW), n = e % MODW; float a = P.b_mod[i * MODW + n];
#pragma unroll
        for (int ks = 0; ks < 16; ++ks) a += MODP[(size_t)ks * DEPTH * 5 * MODW + e];
        MOD[e] = a;
    }
}
#define NC0(j) (512 * ((j) >> 1) + 8 * lane + 4 * ((j) & 1))
template <bool GATES, bool BF16IN>
__device__ __forceinline__ void norm_phase(const float* xl, const float* xc, float* xco, const float* cpart, int ncp, const float* cgate, int nrows, const float* g, const float* modl  , int sh_off, int sc_off, bf16_t* HX,
                                           const float* wg  , const float* bgate, float* GT, LAS unsigned char* lds, int tid, int wave, int lane) {
    LAS float* wl = (LAS float*)lds;
    if (GATES) { for (int i = tid; i < 16 * D; i += NTHR) { const int k = i >> 4, gi = i & 15; wl[gi * D + k] = wg[(size_t)k * APROJ + gi]; } __syncthreads(); }
    const int gw = blockIdx.x * NWAVES + wave, NGW = gridDim.x * NWAVES;
    const int RPW = (TL + NGW - 1) / NGW, r0 = gw * RPW, nl = r0 < TL ? (TL - r0 < RPW ? TL - r0 : RPW) : 0;
    int bcur = -1; f32x4 gsv[4], shv[4];
    int idx0 = 0;
    if (!GATES && BF16IN) {
        for (; idx0 + 4 <= nl; idx0 += 4) {
            const int row = r0 + idx0, b = row >> 13;
            if (b != bcur) { bcur = b; const float* mb = modl + (size_t)b * MODW;
#pragma unroll
                for (int j = 0; j < 4; ++j) { const int c0 = NC0(j); gsv[j] = *(const f32x4*)(g + c0) * (*(const f32x4*)(mb + sc_off + c0) + 1.0f); shv[j] = *(const f32x4*)(mb + sh_off + c0); } }
            const bf16_t* xbr = (const bf16_t*)xl + (size_t)row * D;
            u32x4 w[4][2];
#pragma unroll
            for (int r = 0; r < 4; ++r)
#pragma unroll
                for (int jj = 0; jj < 2; ++jj) w[r][jj] = *(const u32x4*)(xbr + (size_t)r * D + NC0(2 * jj));
            asm volatile("" ::: "memory");
#pragma unroll
            for (int r = 0; r < 4; ++r) {
                f32x4 v[4]; float ss = 0.f;
#pragma unroll
                for (int jj = 0; jj < 2; ++jj) { const u32x4 q = w[r][jj]; v[2 * jj] = (f32x4){bflo(q.x), bfhi(q.x), bflo(q.y), bfhi(q.y)}; v[2 * jj + 1] = (f32x4){bflo(q.z), bfhi(q.z), bflo(q.w), bfhi(q.w)}; }
#pragma unroll
                for (int j = 0; j < 4; ++j) ss += (v[j][0] * v[j][0] + v[j][1] * v[j][1]) + (v[j][2] * v[j][2] + v[j][3] * v[j][3]);
                const float rstd = rsqrtf(wave_sum(ss) * (1.0f / D) + EPS);
#pragma unroll
                for (int j = 0; j < 4; ++j) v[j] = (v[j] * rstd) * gsv[j] + shv[j];
#pragma unroll
                for (int jj = 0; jj < 2; ++jj) { u32x4 o; o.x = pk2(v[2 * jj][0], v[2 * jj][1]); o.y = pk2(v[2 * jj][2], v[2 * jj][3]); o.z = pk2(v[2 * jj + 1][0], v[2 * jj + 1][1]); o.w = pk2(v[2 * jj + 1][2], v[2 * jj + 1][3]);
                    *(u32x4*)(HX + (size_t)(row + r) * D + NC0(2 * jj)) = o; }
            }
        }
    }
    for (int idx = idx0;; ++idx) {
        const int row = idx < nl ? r0 + idx : TL + gw + (idx - nl) * NGW;
        if (row >= nrows) break;
        const float* xr = row < TL ? xl + (size_t)row * D : xc + (size_t)(row - TL) * D;
        const int b = row < TL ? (row >> 13) : 4;
        if (b != bcur) { bcur = b; const float* mb = modl + (size_t)b * MODW;
#pragma unroll
            for (int j = 0; j < 4; ++j) { const int c0 = NC0(j); gsv[j] = *(const f32x4*)(g + c0) * (*(const f32x4*)(mb + sc_off + c0) + 1.0f); shv[j] = *(const f32x4*)(mb + sh_off + c0); } }
        f32x4 v[4]; float ss = 0.f;
        if (BF16IN && row < TL) { const bf16_t* xbr = (const bf16_t*)xl + (size_t)row * D;
#pragma unroll
            for (int jj = 0; jj < 2; ++jj) { const u32x4 w = *(const u32x4*)(xbr + NC0(2 * jj)); v[2 * jj] = (f32x4){bflo(w.x), bfhi(w.x), bflo(w.y), bfhi(w.y)}; v[2 * jj + 1] = (f32x4){bflo(w.z), bfhi(w.z), bflo(w.w), bfhi(w.w)}; }
        } else {
#pragma unroll
            for (int j = 0; j < 4; ++j) v[j] = *(const f32x4*)(xr + NC0(j)); }
        if (ncp > 0 && row >= TL) {
#pragma unroll
            for (int j = 0; j < 4; ++j) { const int c0 = NC0(j); f32x4 s = *(const f32x4*)(cpart + (size_t)(row - TL) * D + c0);
                for (int p = 1; p < ncp; ++p) s = s + *(const f32x4*)(cpart + ((size_t)p * TC + (row - TL)) * D + c0);
                v[j] = v[j] + *(const f32x4*)(cgate + c0) * s; *(f32x4*)(xco + (size_t)(row - TL) * D + c0) = v[j]; } }
#pragma unroll
        for (int j = 0; j < 4; ++j) ss += (v[j][0] * v[j][0] + v[j][1] * v[j][1]) + (v[j][2] * v[j][2] + v[j][3] * v[j][3]);
        const float rstd = rsqrtf(wave_sum(ss) * (1.0f / D) + EPS);
#pragma unroll
        for (int j = 0; j < 4; ++j) v[j] = (v[j] * rstd) * gsv[j] + shv[j];
#pragma unroll
        for (int jj = 0; jj < 2; ++jj) { u32x4 o; o.x = pk2(v[2 * jj][0], v[2 * jj][1]); o.y = pk2(v[2 * jj][2], v[2 * jj][3]); o.z = pk2(v[2 * jj + 1][0], v[2 * jj + 1][1]); o.w = pk2(v[2 * jj + 1][2], v[2 * jj + 1][3]);
            *(u32x4*)(HX + (size_t)row * D + NC0(2 * jj)) = o; }
        if (GATES) {
            float p[16];
#pragma unroll
            for (int gi = 0; gi < 16; ++gi) { float a = 0.f;
#pragma unroll
                for (int j = 0; j < 4; ++j) { const f32x4 w = *(const LAS f32x4*)(wl + gi * D + NC0(j)); a += (v[j][0] * w[0] + v[j][1] * w[1]) + (v[j][2] * w[2] + v[j][3] * w[3]); }
                p[gi] = a; asm volatile("" ::: "memory"); }
#pragma unroll
            for (int i = 0; i < 8; ++i) { const bool up = lane & 1; const float keep = up ? p[2 * i + 1] : p[2 * i], send = up ? p[2 * i] : p[2 * i + 1]; p[i] = keep + __shfl_xor(send, 1); }
#pragma unroll
            for (int i = 0; i < 4; ++i) { const bool up = lane & 2; const float keep = up ? p[2 * i + 1] : p[2 * i], send = up ? p[2 * i] : p[2 * i + 1]; p[i] = keep + __shfl_xor(send, 2); }
#pragma unroll
            for (int i = 0; i < 2; ++i) { const bool up = lane & 4; const float keep = up ? p[2 * i + 1] : p[2 * i], send = up ? p[2 * i] : p[2 * i + 1]; p[i] = keep + __shfl_xor(send, 4); }
            { const bool up = lane & 8; const float keep = up ? p[1] : p[0], send = up ? p[0] : p[1]; p[0] = keep + __shfl_xor(send, 8); }
            float tot = p[0]; tot += __shfl_xor(tot, 16); tot += __shfl_xor(tot, 32);
            if (lane < 16) { const float pre = tot + bgate[lane]; GT[(size_t)lane * TT + row] = lane < 8 ? pre : logsigmoidf_(pre); }
        }
    }
}
#undef NC0
__device__ __forceinline__ void final_norm(const bf16_t* xb, float* out, const float* g, int wave, int lane) {
    const int gw = blockIdx.x * NWAVES + wave, NGW = gridDim.x * NWAVES;
    const int RPW = (TL + NGW - 1) / NGW, r0 = gw * RPW, r1 = r0 + RPW < TL ? r0 + RPW : TL;
    f32x4 gg[4];
#pragma unroll
    for (int j = 0; j < 4; ++j) gg[j] = *(const f32x4*)(g + 512 * (j >> 1) + 8 * lane + 4 * (j & 1));
    for (int row = r0; row < r1; ++row) {
        const bf16_t* xr = xb + (size_t)row * D; f32x4 v[4]; float ss = 0.f;
#pragma unroll
        for (int jj = 0; jj < 2; ++jj) { const u32x4 w = *(const u32x4*)(xr + 512 * jj + 8 * lane); v[2 * jj] = (f32x4){bflo(w.x), bfhi(w.x), bflo(w.y), bfhi(w.y)}; v[2 * jj + 1] = (f32x4){bflo(w.z), bfhi(w.z), bflo(w.w), bfhi(w.w)}; }
#pragma unroll
        for (int j = 0; j < 4; ++j) ss += (v[j][0] * v[j][0] + v[j][1] * v[j][1]) + (v[j][2] * v[j][2] + v[j][3] * v[j][3]);
        const float rstd = rsqrtf(wave_sum(ss) * (1.0f / D) + EPS);
#pragma unroll
        for (int j = 0; j < 4; ++j) *(f32x4*)(out + (size_t)row * D + 512 * (j >> 1) + 8 * lane + 4 * (j & 1)) = (v[j] * rstd) * gg[j];
    }
}
__device__ __forceinline__ void shortconv_ctx_phase(const bf16_t* Pc, bf16_t* Z, const float* wc  , int tid) {
    const long total = (long)TC * (D / 8);
    for (long it = (long)blockIdx.x * NTHR + tid; it < total; it += (long)gridDim.x * NTHR) {
        const int row = (int)(it >> 7), c0 = (int)(it & 127) * 8, t = row & 255;
        const bool hasl = t != 0, hasr = t != 255;
        const bf16_t* pr = Pc + (size_t)row * 3 * D + 256 * (c0 >> 7) + (c0 & 127);
        float bg[8], u0[8], um[8], up[8], a[8], b[8];
        unpack8(*(const u32x4*)(Pc + (size_t)row * 3 * D + 2048 + c0), bg);
        unpack8(*(const u32x4*)pr, a); unpack8(*(const u32x4*)(pr + 128), b);
#pragma unroll
        for (int j = 0; j < 8; ++j) u0[j] = a[j] * b[j];
        if (hasl) { unpack8(*(const u32x4*)(pr - 3 * D), a); unpack8(*(const u32x4*)(pr - 3 * D + 128), b);
#pragma unroll
            for (int j = 0; j < 8; ++j) um[j] = a[j] * b[j]; } else {
#pragma unroll
            for (int j = 0; j < 8; ++j) um[j] = 0.f; }
        if (hasr) { unpack8(*(const u32x4*)(pr + 3 * D), a); unpack8(*(const u32x4*)(pr + 3 * D + 128), b);
#pragma unroll
            for (int j = 0; j < 8; ++j) up[j] = a[j] * b[j]; } else {
#pragma unroll
            for (int j = 0; j < 8; ++j) up[j] = 0.f; }
        float z[8];
#pragma unroll
        for (int j = 0; j < 8; ++j) z[j] = bg[j] * (wc[c0 + j] * um[j] + wc[D + c0 + j] * u0[j] + wc[2 * D + c0 + j] * up[j]);
        u32x4 o; o.x = pk2(z[0], z[1]); o.y = pk2(z[2], z[3]); o.z = pk2(z[4], z[5]); o.w = pk2(z[6], z[7]);
        *(u32x4*)(Z + (size_t)row * D + c0) = o;
    }
}
__device__ __forceinline__ void act_phase(const bf16_t* GV, bf16_t* Aout, const float* wc  , const float* bc  , int nrows, bool is_ctx, int tid) {
    const long total = (long)nrows * (DFF / 8);
    for (long it = (long)blockIdx.x * NTHR + tid; it < total; it += (long)gridDim.x * NTHR) {
        const int row = (int)(it / (DFF / 8)), c0 = (int)(it % (DFF / 8)) * 8;
        bool hasl, hasr; int S;
        if (!is_ctx) { const int r = (row & 8191) >> 6; hasl = r != 0; hasr = r != 127; S = 64; } else { const int t = row & 255; hasl = t != 0; hasr = t != 255; S = 1; }
        const bf16_t* pr = GV + (size_t)row * 2 * DFF + 256 * (c0 >> 7) + (c0 & 127);
        float g0[8], gm[8], gp[8], vv[8];
        unpack8(*(const u32x4*)pr, g0); unpack8(*(const u32x4*)(pr + 128), vv);
        if (hasl) unpack8(*(const u32x4*)(pr - (size_t)S * 2 * DFF), gm); else {
#pragma unroll
            for (int j = 0; j < 8; ++j) gm[j] = 0.f; }
        if (hasr) unpack8(*(const u32x4*)(pr + (size_t)S * 2 * DFF), gp); else {
#pragma unroll
            for (int j = 0; j < 8; ++j) gp[j] = 0.f; }
        float z[8];
#pragma unroll
        for (int j = 0; j < 8; ++j) { const float gt = wc[c0 + j] * gm[j] + wc[DFF + c0 + j] * g0[j] + wc[2 * DFF + c0 + j] * gp[j] + bc[c0 + j]; z[j] = siluf_(gt) * vv[j]; }
        u32x4 o; o.x = pk2(z[0], z[1]); o.y = pk2(z[2], z[3]); o.z = pk2(z[4], z[5]); o.w = pk2(z[6], z[7]);
        *(u32x4*)(Aout + (size_t)row * DFF + c0) = o;
    }
}

constexpr int SCL = 128, NSC = 2 + SEQ / SCL  , NCH = NB * NH * 2  ;
__device__ __forceinline__ int sc_row0(int b, int sc) { return sc < 2 ? TL + b * CTXL + sc * SCL : b * SEQ + (sc - 2) * SCL; }
constexpr float LOG2E = 1.4426950408889634f;
constexpr int QKW = NH * DK;
constexpr int LD136 = 136;
constexpr int HS_LD = 264;

struct GateScan { int tok0, tok1; float gi0, gi1, bc0, bc1, g; };
__device__ __forceinline__ GateScan gate_scan(const float* GT, int dir, int h, int grow0, int lane) {
    GateScan s; s.tok0 = dir ? 127 - 2 * lane : 2 * lane; s.tok1 = dir ? 126 - 2 * lane : 2 * lane + 1;
    const float* gi = GT + (size_t)(dir * 4 + h) * TT + grow0; const float* gf = GT + (size_t)(8 + dir * 4 + h) * TT + grow0;
    s.gi0 = gi[s.tok0]; s.gi1 = gi[s.tok1]; const float f0 = gf[s.tok0], f1 = gf[s.tok1];
    const float incl = prefix_sum64(f0 + f1, lane);
    s.bc0 = incl - f1; s.bc1 = incl; s.g = __shfl(incl, 63);
    return s;
}

__device__ __forceinline__ void mlstm_p1(LAS unsigned char* lds, const bf16_t* Kb, const bf16_t* VT, const float* GT, bf16_t* UC, float* GM, float* NST, int tid, int wave, int lane) {
    LAS float* s_wa = (LAS float*)lds;
    LAS bf16_t* img[2] = {(LAS bf16_t*)(lds + 2048), (LAS bf16_t*)(lds + 2048 + 128 * LD136 * 2)};
    const int l31 = lane & 31, hh = lane >> 5;
    for (int u = blockIdx.x; u < NB * NH * NSC; u += gridDim.x) {
        const int sc = u % NSC, bh = u / NSC, h = bh & 3, b = bh >> 2;
        const int row0 = sc_row0(b, sc);
        const int v = 32 * wave + l31;
        bf16x8 vt[8];
#pragma unroll
        for (int ks = 0; ks < 8; ++ks) vt[ks] = *(const bf16x8*)(VT + ((size_t)(((((row0 >> 7) * 4 + h) * 8 + wave) * 8 + ks) * 2 + hh) * 32 + l31) * 8);
        if (wave < 2) {
            const int dir = wave; const GateScan s = gate_scan(GT, dir, h, row0, lane);
            const float a0 = s.g - s.bc0 + s.gi0, a1 = s.g - s.bc1 + s.gi1, mloc = wave_max(fmaxf(a0, a1));
            s_wa[dir * 128 + s.tok0] = __expf(a0 - mloc); s_wa[dir * 128 + s.tok1] = __expf(a1 - mloc);
            if (lane == 0) { float* gm = GM + ((size_t)((b * 4 + h) * 2 + dir) * NSC + sc) * 4; gm[0] = s.g; gm[1] = mloc; }
        }
        __syncthreads();
#pragma unroll
        for (int k = 0; k < 2; ++k) {
            const int s2 = tid & 63, d8 = ((tid >> 6) + 8 * k) * 8;
            float k0[8], k1[8];
            unpack8(*(const u32x4*)(Kb + (size_t)(row0 + 2 * s2) * QKW + h * DK + d8), k0); unpack8(*(const u32x4*)(Kb + (size_t)(row0 + 2 * s2 + 1) * QKW + h * DK + d8), k1);
#pragma unroll
            for (int dir = 0; dir < 2; ++dir) { const float w0 = s_wa[dir * 128 + 2 * s2], w1 = s_wa[dir * 128 + 2 * s2 + 1];
#pragma unroll
                for (int j = 0; j < 8; ++j) *(LAS unsigned*)(img[dir] + (d8 + j) * LD136 + 2 * s2) = pk2(k0[j] * w0, k1[j] * w1); }
        }
        __syncthreads();
        if (tid < 256) {
            const int dir = tid >> 7, d = tid & 127; float sum = 0.f;
#pragma unroll
            for (int k8 = 0; k8 < 16; ++k8) { float f[8]; unpack8(*(const LAS u32x4*)(img[dir] + d * LD136 + 8 * k8), f);
#pragma unroll
                for (int j = 0; j < 8; ++j) sum += f[j]; }
            NST[((size_t)((b * 4 + h) * 2 + dir) * NSC + sc) * DK + d] = sum;
        }
#pragma unroll
        for (int dir = 0; dir < 2; ++dir) {
            bf16_t* up = UC + ((size_t)((b * 4 + h) * 2 + dir) * NSC + sc) * DV * DK + (wave * 16 * 32 + l31) * 8 + 4 * hh;
#pragma unroll
            for (int dt = 0; dt < 4; ++dt) {
                f32x16 acc;
#pragma unroll
                for (int r = 0; r < 16; ++r) acc[r] = 0.f;
#pragma unroll
                for (int ks = 0; ks < 8; ++ks) { const bf16x8 a = *(const LAS bf16x8*)(img[dir] + (32 * dt + l31) * LD136 + 16 * ks + 8 * hh);
                    acc = __builtin_amdgcn_mfma_f32_32x32x16_bf16(a, vt[ks], acc, 0, 0, 0); }
#pragma unroll
                for (int i4 = 0; i4 < 4; ++i4) { v2u o; o.x = pk2(acc[4 * i4], acc[4 * i4 + 1]); o.y = pk2(acc[4 * i4 + 2], acc[4 * i4 + 3]);
                    *(v2u*)(up + ((4 * (dt & 1) + i4) * 2 + (dt >> 1)) * 256) = o; }
            }
        }
        __syncthreads();
    }
}
__device__ __forceinline__ void mlstm_p2(bf16_t* UC, float* GM, float* NST, int tid) {
    for (int item = blockIdx.x * NTHR + tid; item < NCH * 8192; item += gridDim.x * NTHR) {
        const int ch = item >> 13, e = item & 8191, dir = ch & 1;
        float c0 = 0.f, c1 = 0.f, c2 = 0.f, c3 = 0.f, nn = 0.f, m = 0.f;
        for (int st = 0; st < NSC; st += 6) {
            v2u uu[6]; float gg[6], ml[6], un[6]; int scs[6];
#pragma unroll
            for (int k = 0; k < 6; ++k) { const int s = st + k; const int sc = dir == 0 ? s : (s < 2 ? 1 - s : NSC + 1 - s); scs[k] = sc;
                const size_t ci = (size_t)ch * NSC + sc;
                uu[k] = *(const v2u*)(UC + ci * (DV * DK) + (size_t)e * 4); gg[k] = GM[ci * 4]; ml[k] = GM[ci * 4 + 1];
                un[k] = e < DK ? NST[ci * DK + e] : 0.f; }
#pragma unroll
            for (int k = 0; k < 6; ++k) { const size_t ci = (size_t)ch * NSC + scs[k];
                const float mn = fmaxf(gg[k] + m, ml[k]), dec = __expf(gg[k] + m - mn), sc = __expf(ml[k] - mn);
                v2u o; o.x = pk2(c0, c1); o.y = pk2(c2, c3);
                *(v2u*)(UC + ci * (DV * DK) + (size_t)e * 4) = o;
                if (e < DK) NST[ci * DK + e] = nn;
                if (e == 0) GM[ci * 4 + 2] = m;
                c0 = dec * c0 + sc * bflo(uu[k].x); c1 = dec * c1 + sc * bfhi(uu[k].x); c2 = dec * c2 + sc * bflo(uu[k].y); c3 = dec * c3 + sc * bfhi(uu[k].y);
                nn = dec * nn + sc * un[k]; m = mn; }
        }
    }
}
__device__ __forceinline__ void mlstm_p3(LAS unsigned char* lds, const bf16_t* Qb, const bf16_t* Ob, const bf16_t* Kb, const bf16_t* VT, const bf16_t* UC, const float* GM, const float* NST,
                                         const float* GT, const float* gain, bf16_t* HN, bool emit_ctx, int tid, int wave, int lane) {
    LAS float* s_bc = (LAS float*)lds;
    LAS float* s_ii = s_bc + 256;
    LAS float* s_mt = s_ii + 256;
    LAS float* s_wi = s_mt + 256;
    LAS float* s_r = s_wi + 256;
    LAS float* s_n0 = s_r + 128;
    LAS bf16_t* Qi = (LAS bf16_t*)(lds + 8192);
    LAS bf16_t* Ki = Qi + 64 * LD136;
    LAS bf16_t* Wi[2] = {Ki + 128 * LD136, Ki + 128 * LD136 + 64 * LD136};
    LAS bf16_t* Qp[2] = {Wi[1] + 64 * LD136, Wi[1] + 128 * LD136};
    LAS float* Hs = (LAS float*)(lds + 8192 + (64 + 128) * LD136 * 2);
    LAS float* s_dp = (LAS float*)(lds + 130048);
    const int l31 = lane & 31, hh = lane >> 5, l15 = lane & 15, q4 = lane >> 4;
    const int nsq = emit_ctx ? NSC : NSC - 2, nun = NB * NH * nsq;
    if ((int)blockIdx.x < nun) {
        const int u = blockIdx.x, sc = (u % nsq) + (emit_ctx ? 0 : 2), bh = u / nsq, h = bh & 3, b = bh >> 2, srow0 = sc_row0(b, sc);
#pragma unroll
        for (int k = 0; k < 4; ++k) { const int q = tid + NTHR * k, r = q >> 4, c8 = (q & 15) * 8;
            *(LAS u32x4*)(Ki + r * LD136 + c8) = *(const u32x4*)(Kb + (size_t)(srow0 + r) * QKW + h * DK + c8); }
#pragma unroll
        for (int k = 0; k < 2; ++k) { const int q = tid + NTHR * k, r = q >> 4, c8 = (q & 15) * 8;
            *(LAS u32x4*)(Qi + r * LD136 + c8) = *(const u32x4*)(Qb + (size_t)(srow0 + r) * QKW + h * DK + c8); }
    }
    for (int u = blockIdx.x; u < nun; u += gridDim.x) {
        const int sc = (u % nsq) + (emit_ctx ? 0 : 2), bh = u / nsq, h = bh & 3, b = bh >> 2;
        const int srow0 = sc_row0(b, sc);
        const int chF = (b * 4 + h) * 2;
        const int v = 32 * wave + l31;
        const int un = u + gridDim.x; const bool has_next = un < nun;
        const int scn = (un % nsq) + (emit_ctx ? 0 : 2), bhn = un / nsq, hn = bhn & 3;
        const int srow0n = has_next ? sc_row0(bhn >> 2, scn) : srow0;
        int tl = tid; asm volatile("" : "+v"(tl));
        if (wave < 2) {
            const int dir = wave; const GateScan s = gate_scan(GT, dir, h, srow0, lane);
            const float m0 = GM[((size_t)(chF + dir) * NSC + sc) * 4 + 2];
            const float e0 = s.gi0 - s.bc0, e1 = s.gi1 - s.bc1;
            const float pmx = prefix_max64(fmaxf(e0, e1), lane); float exm = __shfl_up(pmx, 1); if (lane == 0) exm = -3.0e38f;
            const float pm0 = fmaxf(exm, e0), pm1 = pmx;
            s_bc[dir * 128 + s.tok0] = (s.gi0 - s.bc0) * LOG2E; s_bc[dir * 128 + s.tok1] = (s.gi1 - s.bc1) * LOG2E;
            { const float mt = s.bc0 + fmaxf(m0, pm0); s_mt[dir * 128 + s.tok0] = mt; s_ii[dir * 128 + s.tok0] = (s.bc0 - mt) * LOG2E; s_wi[dir * 128 + s.tok0] = __expf(s.bc0 + m0 - mt); }
            { const float mt = s.bc1 + fmaxf(m0, pm1); s_mt[dir * 128 + s.tok1] = mt; s_ii[dir * 128 + s.tok1] = (s.bc1 - mt) * LOG2E; s_wi[dir * 128 + s.tok1] = __expf(s.bc1 + m0 - mt); }
        } else if (wave < 6) { const int i = tid - 128, dir = i >> 7, d = i & 127; s_n0[i] = NST[((size_t)(chF + dir) * NSC + sc) * DK + d]; }
#pragma unroll 1
        for (int half = 0; half < 2; ++half) {
            const int qrow0 = srow0 + 64 * half;
            int th = tl; asm volatile("" : "+v"(th));
            const int tid = th, lane = th & 63, l31 = lane & 31, hh = lane >> 5, l15 = lane & 15, q4 = lane >> 4, v = 32 * wave + l31;
            __syncthreads();
#pragma unroll
            for (int k4 = 0; k4 < 4; ++k4) {
                const int idx = 4 * wave + k4, si = idx >> 2, ti = idx & 3;
                f32x4 acc = {0.f, 0.f, 0.f, 0.f};
#pragma unroll
                for (int ks = 0; ks < 4; ++ks) { const bf16x8 a = *(const LAS bf16x8*)(Ki + (16 * si + l15) * LD136 + 32 * ks + 8 * q4), bq = *(const LAS bf16x8*)(Qi + (16 * ti + l15) * LD136 + 32 * ks + 8 * q4);
                    acc = __builtin_amdgcn_mfma_f32_16x16x32_bf16(a, bq, acc, 0, 0, 0); }
                const int t = 16 * ti + l15, tg = 64 * half + t, s0 = 16 * si + 4 * q4;
                const int rel = si - (4 * half + ti);
#pragma unroll
                for (int dir = 0; dir < 2; ++dir) {
                    const bool zero = dir == 0 ? rel > 0 : rel < 0, full = dir == 0 ? rel < 0 : rel > 0;
                    if (zero) { v2u o; o.x = 0u; o.y = 0u; *(LAS v2u*)(Wi[dir] + t * LD136 + s0) = o; if (q4 == 0) s_dp[(dir * 64 + t) * 9 + si] = 0.f; }
                    else {
                        const float qq = s_ii[dir * 128 + tg]; const f32x4 kq = *(const LAS f32x4*)(s_bc + dir * 128 + s0); float ev[4];
#pragma unroll
                        for (int j = 0; j < 4; ++j) ev[j] = __builtin_amdgcn_exp2f(qq + kq[j]);
                        if (!full) {
#pragma unroll
                            for (int j = 0; j < 4; ++j) { const int s = s0 + j; const bool ok = dir == 0 ? (s <= tg) : (s >= tg); ev[j] = ok ? ev[j] : 0.f; } }
                        v2u o; o.x = pk2(ev[0] * acc[0], ev[1] * acc[1]); o.y = pk2(ev[2] * acc[2], ev[3] * acc[3]);
                        *(LAS v2u*)(Wi[dir] + t * LD136 + s0) = o;
                        float sum = (bflo(o.x) + bfhi(o.x)) + (bflo(o.y) + bfhi(o.y));
                        sum += __shfl_xor(sum, 16); sum += __shfl_xor(sum, 32);
                        if (q4 == 0) s_dp[(dir * 64 + t) * 9 + si] = sum;
                    }
                }
            }
            { const int dir = tid >> 8, t = (tid >> 2) & 63, part = tid & 3; const float wi = s_wi[dir * 128 + 64 * half + t]; float qn = 0.f;
#pragma unroll
              for (int k = 0; k < 4; ++k) { float qf[8]; unpack8(*(const LAS u32x4*)(Qi + t * LD136 + 32 * part + 8 * k), qf);
                  u32x4 o; o.x = pk2(wi * qf[0], wi * qf[1]); o.y = pk2(wi * qf[2], wi * qf[3]); o.z = pk2(wi * qf[4], wi * qf[5]); o.w = pk2(wi * qf[6], wi * qf[7]);
                  *(LAS u32x4*)(Qp[dir] + t * LD136 + 32 * part + 8 * k) = o;
                  const f32x4 na = *(const LAS f32x4*)(s_n0 + dir * 128 + 32 * part + 8 * k), nb = *(const LAS f32x4*)(s_n0 + dir * 128 + 32 * part + 8 * k + 4);
                  qn += (bflo(o.x) * na[0] + bfhi(o.x) * na[1]) + (bflo(o.y) * na[2] + bfhi(o.y) * na[3]) + (bflo(o.z) * nb[0] + bfhi(o.z) * nb[1]) + (bflo(o.w) * nb[2] + bfhi(o.w) * nb[3]); }
              qn += __shfl_xor(qn, 1); qn += __shfl_xor(qn, 2);
              if (part == 0) s_dp[(dir * 64 + t) * 9 + 8] = qn; }
            bf16x8 cf[2][8];
#pragma unroll
            for (int dir = 0; dir < 2; ++dir)
#pragma unroll
                for (int ks = 0; ks < 8; ++ks) cf[dir][ks] = *(const bf16x8*)(UC + ((size_t)(chF + dir) * NSC + sc) * DV * DK + (((wave * 8 + ks) * 2 + hh) * 32 + l31) * 8);
            __syncthreads();
            if (tid < 128) { float den = 0.f;
#pragma unroll
                for (int q = 0; q < 9; ++q) den += s_dp[tid * 9 + q];
                s_r[tid] = 1.0f / fmaxf(fabsf(den), __expf(-s_mt[(tid >> 6) * 128 + 64 * half + (tid & 63)])); }
            const bool pfq = half == 0 || has_next, pfk = half == 1 && has_next;
            u32x4 pq[2], pk[4];
            { const int nrow0 = half == 0 ? srow0 + 64 : srow0n, nh = half == 0 ? h : hn;
              if (pfq) {
#pragma unroll
                  for (int k = 0; k < 2; ++k) { const int q = tl + NTHR * k, r = q >> 4, c8 = (q & 15) * 8; pq[k] = *(const u32x4*)(Qb + (size_t)(nrow0 + r) * QKW + nh * DK + c8); } }
              if (pfk) {
#pragma unroll
                  for (int k = 0; k < 4; ++k) { const int q = tl + NTHR * k, r = q >> 4, c8 = (q & 15) * 8; pk[k] = *(const u32x4*)(Kb + (size_t)(srow0n + r) * QKW + hn * DK + c8); } } }
            asm volatile("" ::: "memory");
            f32x16 acc[2][2];
#pragma unroll
            for (int tt = 0; tt < 2; ++tt) {
#pragma unroll
                for (int r = 0; r < 16; ++r) acc[0][tt][r] = 0.f;
#pragma unroll
                for (int ks = 0; ks < 8; ++ks) { const bf16x8 a = *(const LAS bf16x8*)(Qp[0] + (32 * tt + l31) * LD136 + 64 * hh + 8 * ks);
                    acc[0][tt] = __builtin_amdgcn_mfma_f32_32x32x16_bf16(a, cf[0][ks], acc[0][tt], 0, 0, 0); }
            }
            bf16x8 vt[8];
#pragma unroll
            for (int ks = 0; ks < 8; ++ks) vt[ks] = *(const bf16x8*)(VT + ((size_t)(((((srow0 >> 7) * 4 + h) * 8 + wave) * 8 + ks) * 2 + hh) * 32 + l31) * 8);
            asm volatile("" ::: "memory");
#pragma unroll
            for (int tt = 0; tt < 2; ++tt) {
#pragma unroll
                for (int r = 0; r < 16; ++r) acc[1][tt][r] = 0.f;
#pragma unroll
                for (int ks = 0; ks < 8; ++ks) { const bf16x8 a = *(const LAS bf16x8*)(Qp[1] + (32 * tt + l31) * LD136 + 64 * hh + 8 * ks);
                    acc[1][tt] = __builtin_amdgcn_mfma_f32_32x32x16_bf16(a, cf[1][ks], acc[1][tt], 0, 0, 0); }
            }
            if (pfq) {
#pragma unroll
                for (int k = 0; k < 2; ++k) { const int q = tl + NTHR * k, r = q >> 4, c8 = (q & 15) * 8; *(LAS u32x4*)(Qi + r * LD136 + c8) = pq[k]; } }
            if (pfk) {
#pragma unroll
                for (int k = 0; k < 4; ++k) { const int q = tl + NTHR * k, r = q >> 4, c8 = (q & 15) * 8; *(LAS u32x4*)(Ki + r * LD136 + c8) = pk[k]; } }
            asm volatile("" ::: "memory");
#pragma unroll
            for (int dir = 0; dir < 2; ++dir)
#pragma unroll
                for (int tt = 0; tt < 2; ++tt)
#pragma unroll
                    for (int ks = 0; ks < 8; ++ks) { const bf16x8 a = *(const LAS bf16x8*)(Wi[dir] + (32 * tt + l31) * LD136 + 16 * ks + 8 * hh);
                        acc[dir][tt] = __builtin_amdgcn_mfma_f32_32x32x16_bf16(a, vt[ks], acc[dir][tt], 0, 0, 0); }
            __syncthreads();
#pragma unroll
            for (int tt = 0; tt < 2; ++tt)
#pragma unroll
                for (int r = 0; r < 16; ++r) { const int t = 32 * tt + (r & 3) + 8 * (r >> 2) + 4 * hh; Hs[t * HS_LD + v] = s_r[t] * acc[0][tt][r] + s_r[64 + t] * acc[1][tt][r]; }
            u32x4 ov[4];
#pragma unroll
            for (int k4 = 0; k4 < 4; ++k4) ov[k4] = *(const u32x4*)(Ob + (size_t)(qrow0 + (tl >> 3)) * D + h * DV + 32 * (tl & 7) + 8 * k4);
            __syncthreads();
            { const int t = tid >> 3, seg = tid & 7;
              f32x4 hq[8]; float ss = 0.f;
#pragma unroll
              for (int k = 0; k < 8; ++k) { hq[k] = *(const LAS f32x4*)(Hs + t * HS_LD + 32 * seg + 4 * k); ss += (hq[k][0] * hq[k][0] + hq[k][1] * hq[k][1]) + (hq[k][2] * hq[k][2] + hq[k][3] * hq[k][3]); }
              ss += __shfl_xor(ss, 1); ss += __shfl_xor(ss, 2); ss += __shfl_xor(ss, 4);
              const float rstd = rsqrtf(ss * (1.0f / DV) + EPS);
              bf16_t* op = HN + (size_t)(qrow0 + t) * D + h * DV + 32 * seg;
#pragma unroll
              for (int k4 = 0; k4 < 4; ++k4) { float of[8]; unpack8(ov[k4], of); float y[8];
                  const f32x4 ga = *(const f32x4*)(gain + h * DV + 32 * seg + 8 * k4), gb = *(const f32x4*)(gain + h * DV + 32 * seg + 8 * k4 + 4);
#pragma unroll
                  for (int j = 0; j < 8; ++j) { const int c = 8 * k4 + j; y[j] = hq[c >> 2][c & 3] * (rstd * (j < 4 ? ga[j & 3] : gb[j & 3])) * sigmoidf_(of[j]); }
                  u32x4 w; w.x = pk2(y[0], y[1]); w.y = pk2(y[2], y[3]); w.z = pk2(y[4], y[5]); w.w = pk2(y[6], y[7]);
                  *(u32x4*)(op + 8 * k4) = w; } }
            __syncthreads();
        }
    }
}
}

#ifndef MK_MULTI
#define MK_MULTI 0
#endif
struct Args { Ptrs p; int ph_lo, ph_hi; };
constexpr int PH_MLSTM = 6, PH_SCONV = 4;
constexpr int NPHASES = 2 + 2 * (PH_MLSTM + PH_SCONV) + (4 + 4 + 3 + 3) + 1;

__global__ void __launch_bounds__(NTHR, 2) fwd_kernel(Args args) {
    extern __shared__ __attribute__((aligned(16))) unsigned char lds_raw[];
    LAS unsigned char* lds = (LAS unsigned char*)lds_raw;
    const Ptrs& P = args.p;
    volatile LAS unsigned* MISC = (volatile LAS unsigned*)(lds + MISC_OFF);
    if (threadIdx.x < 32) MISC[threadIdx.x] = 0u;
    __syncthreads();
    unsigned* ctl = (unsigned*)(P.ws + WS_CTL);
    XcdBarrier bar; bar.bar = ctl + CW_BAR; bar.x = 0; bar.st = nullptr;
    if (!MK_MULTI) bar = xcd_barrier_post(ctl + CW_BAR, MISC + 8);
    const int lo = args.ph_lo, hi = args.ph_hi;
    int ph = 0;
#define PH_BEGIN if (ph >= lo && ph < hi) { int tid_l = threadIdx.x; asm volatile("" : "+v"(tid_l)); const int tid = tid_l, lane = tid & 63, wave = __builtin_amdgcn_readfirstlane(tid >> 6); (void)lane; (void)wave;
#define PH_END   if (ph + 1 < hi) xcd_barrier(bar); else { asm volatile("s_waitcnt vmcnt(0)" ::: "memory"); __syncthreads(); } } ++ph;

    unsigned char* ws = P.ws;
    float* MOD = (float*)(ws + WS_MOD);
    float* GT = (float*)(ws + WS_GATES);
    float* GM = (float*)(ws + WS_GM);
    float* NST = (float*)(ws + WS_NST);
    float* CTXRES = (float*)(ws + WS_CTXRES);
    bf16_t* WB = (bf16_t*)(ws + WS_W);
    bf16_t* HX = (bf16_t*)(ws + WS_HX);
    unsigned char* BIG = ws + WS_BIG;
    bf16_t* XB = (bf16_t*)P.out;
    bf16_t* XF = (bf16_t*)(BIG + BIG_XF);
    float* CPART = (float*)(BIG + BIG_CPART);

    PH_BEGIN
        p0_convert(P, lds, wave, lane);
        __syncthreads();
        p0_mod(P, lds, tid);
        {
            bf16_t* WG = WB + W_AING / 2;
            for (int e = blockIdx.x * NTHR + tid; e < 2 * 256 * D; e += gridDim.x * NTHR) {
                const int j = e >> 18, n = (e >> 10) & 255, k = e & 1023; float w = 0.f;
                if (n < 32) { const float f = P.a_w_in[((size_t)j * D + k) * APROJ + 3072 + (n & 15)]; const float hi = bfround(f); w = n < 16 ? hi : f - hi; }
                WG[e] = (bf16_t)f2bf(w);
            }
        }
    PH_END
    PH_BEGIN
        mod_reduce(P, tid);
    PH_END

#pragma unroll 1
    for (int lp = 0; lp < 2; ++lp) {
        {
            const int i = 2 * lp, j = lp;
            const float* xc = i == 0 ? P.ctx : CTXRES;
            const float* modl = MOD + (size_t)i * 5 * MODW;
            const bool emit_ctx = i == 0;
            bf16_t* Qb = (bf16_t*)(BIG + BIG_Q); bf16_t* Ob = (bf16_t*)(BIG + BIG_O); bf16_t* Kb = (bf16_t*)(BIG + BIG_K); bf16_t* VT = (bf16_t*)(BIG + BIG_VT); bf16_t* UC = (bf16_t*)(BIG + BIG_UC);
            const bf16_t* Wain = WB + W_AIN / 2 + (size_t)j * 3072 * D;
            PH_BEGIN
if (i == 0) norm_phase<false, false>(P.x, xc, CTXRES, CPART, 0, MOD, TT, P.g_mix + (size_t)i * D, modl, 0, D, HX, nullptr, nullptr, nullptr, lds, tid, wave, lane); else norm_phase<false, true>((const float*)XB, xc, CTXRES, CPART, 4, MOD + (size_t)(i - 1) * 5 * MODW + 4 * MODW + 5 * D, TT, P.g_mix + (size_t)i * D, modl, 0, D, HX, nullptr, nullptr, nullptr, lds, tid, wave, lane);
            PH_END
            PH_BEGIN
                {
                    EpiQOK E{Qb, Ob, Kb, 0};
                    run_gemm(lds, HX, Wain, TL, 2048, D, E);
                    EpiQOK Ec{Qb, Ob, Kb, TL};
                    run_gemm(lds, HX + (size_t)TL * D, Wain, TC, 2048, D, Ec);
                }
                {
                    EpiVT E{VT, 0};
                    run_gemm(lds, Wain + (size_t)2048 * D, HX, 1024, TL, D, E);
                    EpiVT Ec{VT, TL};
                    run_gemm(lds, Wain + (size_t)2048 * D, HX + (size_t)TL * D, 1024, TC, D, Ec, 240);
                }
                {
                    const bf16_t* Wg = WB + W_AING / 2 + (size_t)j * 256 * D;
                    EpiGates Eg{GT, P.a_b_gate + j * 16, 0};
                    run_gemm(lds, HX, Wg, TL, 256, D, Eg, 32);
                    EpiGates Egc{GT, P.a_b_gate + j * 16, TL};
                    run_gemm(lds, HX + (size_t)TL * D, Wg, TC, 256, D, Egc, 160);
                }
            PH_END
            PH_BEGIN
mlstm_p1(lds, Kb, VT, GT, UC, GM, NST, tid, wave, lane);
            PH_END
            PH_BEGIN
                mlstm_p2(UC, GM, NST, tid);
            PH_END
            PH_BEGIN
mlstm_p3(lds, Qb, Ob, Kb, VT, UC, GM, NST, GT, P.a_head_gain + (size_t)j * D, HX, emit_ctx, tid, wave, lane);
            PH_END
            PH_BEGIN
                {
                    if (i == 0) { EpiResidual<true, true> E{P.x, XB, modl + 2 * D, 32}; run_gemm(lds, HX, WB + W_AOUT / 2 + (size_t)j * D * D, TL, D, D, E); }
                    else { EpiResidual<false, true> E{XB, XB, modl + 2 * D, 32}; run_gemm(lds, HX, WB + W_AOUT / 2 + (size_t)j * D * D, TL, D, D, E); }
                    if (emit_ctx) {
                        EpiPartF32 E0{CPART}, E1{CPART + (size_t)TC * D};
                        run_gemm_slice(lds, HX + (size_t)TL * D, WB + W_AOUT / 2 + (size_t)j * D * D, TC, D, 0, 512, D, 0, E0);
                        run_gemm_slice(lds, HX + (size_t)TL * D, WB + W_AOUT / 2 + (size_t)j * D * D, TC, D, 512, 512, D, 128, E1); }
                }
            PH_END
        }
#pragma unroll 1
        for (int sub = 0; sub < 2; ++sub) {
            const int i = 2 * lp + sub;
            const float* modl = MOD + (size_t)i * 5 * MODW;
            const bool ctx_live = i < 2;
            if (sub == 1) {
                const int j = lp;
                bf16_t* CU = (bf16_t*)(BIG + BIG_CU); bf16_t* Z = (bf16_t*)(BIG + BIG_Z); bf16_t* Pc = (bf16_t*)(BIG + BIG_PC);
                const bf16_t* Wbin = WB + W_BIN / 2 + (size_t)j * 3 * D * D;
                const int nrows = ctx_live ? TT : TL;
                PH_BEGIN
norm_phase<false, true>((const float*)XB, CTXRES, CTXRES, CPART, ctx_live ? 4 : 0, MOD + (size_t)(i - 1) * 5 * MODW + 4 * MODW + 5 * D, nrows, P.g_mix + (size_t)i * D, modl, 0, D, HX, nullptr, nullptr, nullptr, lds, tid, wave, lane);
                PH_END
                PH_BEGIN
{ EpiConvU E{CU, P.b_w_conv + (size_t)j * 3 * D}; run_gemm<EpiConvU, SeqStripA>(lds, HX, Wbin, TL, 2 * D, D, E); }
                    if (ctx_live) { EpiStoreBf16 Ec{Pc, 3 * D, 0, 0}; run_gemm(lds, HX + (size_t)TL * D, Wbin, TC, 3 * D, D, Ec); }
                PH_END
                PH_BEGIN
{ EpiMulZ E{CU, Z}; run_gemm(lds, HX, Wbin + (size_t)2 * D * D, TL, D, D, E); }
                    if (ctx_live) shortconv_ctx_phase(Pc, Z + (size_t)TL * D, P.b_w_conv + (size_t)j * 3 * D, tid);
                PH_END
                PH_BEGIN
                    {
                        EpiResidual<false, true> E{XB, XB, modl + 2 * D, 32};
                        run_gemm(lds, Z, WB + W_BOUT / 2 + (size_t)j * D * D, TL, D, D, E);
                        if (ctx_live) { EpiPartF32 E0{CPART}, E1{CPART + (size_t)TC * D};
                            run_gemm_slice(lds, Z + (size_t)TL * D, WB + W_BOUT / 2 + (size_t)j * D * D, TC, D, 0, 512, D, 0, E0);
                            run_gemm_slice(lds, Z + (size_t)TL * D, WB + W_BOUT / 2 + (size_t)j * D * D, TC, D, 512, 512, D, 128, E1); }
                    }
                PH_END
            }
            {
                bf16_t* Abuf = (bf16_t*)(BIG + BIG_A); bf16_t* GVC = (bf16_t*)(BIG + BIG_GVC);
                const bf16_t* Wup = WB + W_UP / 2 + (size_t)i * 2 * DFF * D; const bf16_t* Wdn = WB + W_DN / 2 + (size_t)i * D * DFF;
                const int nrows = ctx_live ? TT : TL;
                PH_BEGIN
norm_phase<false, true>((const float*)XB, i == 0 ? P.ctx : CTXRES, CTXRES, CPART, ctx_live ? 2 : 0, modl + 4 * MODW + 2 * D, nrows, P.g_ffn + (size_t)i * D, modl, 3 * D, 4 * D, HX, nullptr, nullptr, nullptr, lds, tid, wave, lane);
                PH_END
                PH_BEGIN
{ EpiConvGLU E{Abuf, P.f_w_conv + (size_t)i * 3 * DFF, P.f_b_conv + (size_t)i * DFF}; run_gemm<EpiConvGLU, ColStripA>(lds, HX, Wup, TL, 2 * DFF, D, E); }
                    if (ctx_live) { EpiStoreBf16 Ec{GVC, 2 * DFF, 0, 0}; run_gemm(lds, HX + (size_t)TL * D, Wup, TC, 2 * DFF, D, Ec); }
                PH_END
                if (ctx_live) {
                    PH_BEGIN
                        act_phase(GVC, Abuf + (size_t)TL * DFF, P.f_w_conv + (size_t)i * 3 * DFF, P.f_b_conv + (size_t)i * DFF, TC, true, tid);
                    PH_END
                }
                PH_BEGIN
                    {
                        { EpiResidual<false, true> E{XB, i == 3 ? XF : XB, modl + 5 * D, 32}; run_gemm(lds, Abuf, Wdn, TL, D, DFF, E); }
                        if (ctx_live) {
                            EpiPartF32 E0{CPART}, E1{CPART + (size_t)TC * D}, E2{CPART + (size_t)2 * TC * D}, E3{CPART + (size_t)3 * TC * D};
                            run_gemm_slice(lds, Abuf + (size_t)TL * DFF, Wdn, TC, D, 0, 768, DFF, 0, E0);
                            run_gemm_slice(lds, Abuf + (size_t)TL * DFF, Wdn, TC, D, 768, 768, DFF, 64, E1);
                            run_gemm_slice(lds, Abuf + (size_t)TL * DFF, Wdn, TC, D, 1536, 640, DFF, 128, E2);
                            run_gemm_slice(lds, Abuf + (size_t)TL * DFF, Wdn, TC, D, 2176, 640, DFF, 192, E3); }
                    }
                PH_END
            }
        }
    }
    PH_BEGIN
        final_norm(XF, P.out, P.g_final, wave, lane);
    PH_END
#undef PH_BEGIN
#undef PH_END
}

extern "C" void kernel_launch(void* const* d_in, const int* in_sizes, int n_in, void* d_out, int out_size, void* d_ws, size_t ws_size, hipStream_t stream) {
    static int grid = 0;
    if (grid == 0) {
        if (n_in != 20 || out_size != TL * D || ws_size < WS_END) { fprintf(stderr, "kernel_launch: unexpected problem (n_in %d, out %d, ws %zu < %zu)\n", n_in, out_size, ws_size, (size_t)WS_END); grid = -1; return; }
        int dev = 0, cus = 0, per_cu = 0;
        if (hipGetDevice(&dev) != hipSuccess || hipDeviceGetAttribute(&cus, hipDeviceAttributeMultiprocessorCount, dev) != hipSuccess) { grid = -1; return; }
        if (hipFuncSetAttribute((const void*)fwd_kernel, hipFuncAttributeMaxDynamicSharedMemorySize, LDS_BYTES) != hipSuccess) { grid = -1; return; }
        if (hipOccupancyMaxActiveBlocksPerMultiprocessor(&per_cu, (const void*)fwd_kernel, NTHR, LDS_BYTES) != hipSuccess || per_cu < 1) { fprintf(stderr, "kernel_launch: occupancy query says %d\n", per_cu); }
        (void)hipGetLastError();
        grid = cus;
    }
    if (grid < 0) return;
    (void)hipMemsetAsync((char*)d_ws + WS_CTL, 0, CTL_ZERO_BYTES, stream);
    Args a{};
    const float* const* in = (const float* const*)d_in;
    a.p.x = in[0]; a.p.c = in[1]; a.p.ctx = in[2]; a.p.c_ctx = in[3]; a.p.w_mod = in[4]; a.p.b_mod = in[5]; a.p.g_mix = in[6]; a.p.g_ffn = in[7];
    a.p.a_w_in = in[8]; a.p.a_b_gate = in[9]; a.p.a_head_gain = in[10]; a.p.a_w_out = in[11]; a.p.b_w_in = in[12]; a.p.b_w_conv = in[13]; a.p.b_w_out = in[14];
    a.p.f_w_up = in[15]; a.p.f_w_conv = in[16]; a.p.f_b_conv = in[17]; a.p.f_w_down = in[18]; a.p.g_final = in[19];
    a.p.out = (float*)d_out; a.p.ws = (unsigned char*)d_ws;
#if MK_MULTI
    for (int p = 0; p < NPHASES; ++p) { a.ph_lo = p; a.ph_hi = p + 1; hipLaunchKernelGGL(fwd_kernel, dim3(grid), dim3(NTHR), LDS_BYTES, stream, a); }
#else
    a.ph_lo = 0; a.ph_hi = NPHASES;
    hipLaunchKernelGGL(fwd_kernel, dim3(grid), dim3(NTHR), LDS_BYTES, stream, a);
#endif
}
```

```cpp
#include <hip/hip_runtime.h>
#include <cstdio>
#include <cstdint>
namespace pg8 {
#define PG8_LAS __attribute__((address_space(3)))
typedef unsigned short bf16_t;
typedef short bf16x8 __attribute__((ext_vector_type(8)));
typedef float f32x4 __attribute__((ext_vector_type(4)));
typedef unsigned u32x4 __attribute__((ext_vector_type(4)));
constexpr int BM = 256, BK = 64, HALF = 128, HTB = HALF * BK * 2  , STAGE_BYTES = 8 * HTB, NXCD = 8, WGM = 8;

__host__ __device__ __forceinline__ int lds_byte(int r, int c) { const int st = (r >> 4) * 2 + (c >> 5), rr = r & 15, cc = c & 31, ob = rr * 64 + cc * 2; return st * 1024 + (ob ^ (((ob >> 9) & 1) << 5)); }
__host__ __device__ __forceinline__ void stage_rc(int b, int& R, int& C) { const int st = b / 1024, sb = b % 1024, swz = sb ^ (((sb >> 9) & 1) << 5); R = (st >> 1) * 16 + swz / 64; C = (st & 1) * 32 + (swz % 64) / 2; }
__host__ __device__ __forceinline__ int perm32(int rho) { const int n = rho >> 4, i = rho & 15; return 8 * (i >> 2) + 4 * n + (i & 3); }

struct Unit { int pm, pn; };
struct Gemm { const bf16_t* A; const bf16_t* Bt; int M, N, K; int ld = 0; };

struct StaticOrder {
    int nM, nN, nwg, G, c;
    __host__ __device__ void init(int M, int N, int G_, int c_) { nM = M / BM; nN = N / BM; nwg = nM * nN; G = G_; c = c_; }
    __host__ __device__ bool next(int i, Unit& u) const {
        const long L = (long)i * G + c; if (L >= nwg) return false;
        int wgid = (int)L; { const int q = nwg / NXCD, r = nwg % NXCD, xcd = wgid % NXCD, off = wgid / NXCD; wgid = (xcd < r ? xcd * (q + 1) : r * (q + 1) + (xcd - r) * q) + off; }
        const int nig = WGM * nN, gid = wgid / nig, fm = gid * WGM, gsz = (nM - fm) < WGM ? (nM - fm) : WGM;
        u.pm = fm + ((wgid % nig) % gsz); u.pn = (wgid % nig) / gsz; return true;
    }
    __device__ __forceinline__ void a_ready(const Unit&) const {}
    __device__ __forceinline__ void done(const Unit&) const {}
};

__device__ __forceinline__ unsigned cvt_pk_bf16(float lo, float hi) { unsigned r; asm volatile("v_cvt_pk_bf16_f32 %0, %1, %2" : "=v"(r) : "v"(lo), "v"(hi)); return r; }

struct NatA {
    static __device__ __forceinline__ unsigned voff(int R, int C, int K) { return (unsigned)(R * K + C) * 2u; }
    static __device__ __forceinline__ size_t hstep(int K) { return (size_t)HALF * K * 2; }
    static __device__ __forceinline__ size_t tbase(int pm, int K) { return (size_t)pm * 2 * HALF * K * 2; }
};
template <class Epi, class Sched, bool ALIGN_EPI = false, bool SP2 = false, class AM = NatA>
__device__ __forceinline__ void gemm_phase(PG8_LAS unsigned char* lds, const Gemm g, const Sched& S, const Epi& E) {
    int tid_l = threadIdx.x; asm volatile("" : "+v"(tid_l));
    const int tid = tid_l, wid = __builtin_amdgcn_readfirstlane(tid >> 6), lane = tid & 63, wr = wid >> 2, wc = wid & 3, fr = lane & 15, fq = lane >> 4;
    const int K = g.ld ? g.ld : g.K, nt = g.K / BK;
    unsigned voffA[2], voffB[2];
#pragma unroll
    for (int i = 0; i < 2; ++i) { int R, C; stage_rc(tid * 16 + i * 8192, R, C); const int Rb = Epi::PERM ? ((R & ~31) + perm32(R & 31)) : R;
        voffA[i] = AM::voff(R, C, K); voffB[i] = (unsigned)(Rb * K + C) * 2u; }
    const size_t kstep = (size_t)(BK * 2);
    const size_t hstep = (size_t)HALF * K * 2;
    const size_t hstepA = AM::hstep(K);
    const size_t tstep = 2 * hstep;
    const unsigned ldsw = (unsigned)wid * 1024u;
    const int aoff = lds_byte(wr * 64 + fr, fq * 8), boff = lds_byte(wc * 32 + fr, fq * 8);
#define PG8_SA(b, h) (((b) * 2 + (h)) * HTB)
#define PG8_SB(b, h) ((4 + (b) * 2 + (h)) * HTB)
#define PG8_STAGE(bufoff, gbase, voff) do { _Pragma("unroll") for (int _i = 0; _i < 2; ++_i) \
        __builtin_amdgcn_global_load_lds((const unsigned*)((const char*)(gbase) + (voff)[_i]), (PG8_LAS unsigned*)(lds + (bufoff) + ldsw + _i * 8192), 16, 0, 0); } while (0)
#define PG8_LDA(dst, b, h) do { _Pragma("unroll") for (int m = 0; m < 4; ++m) _Pragma("unroll") for (int k = 0; k < 2; ++k) dst[m][k] = *(const PG8_LAS bf16x8*)(lds + PG8_SA(b, h) + aoff + m * 2048 + k * 1024); } while (0)
#define PG8_LDB(dst, b, h) do { _Pragma("unroll") for (int n = 0; n < 2; ++n) _Pragma("unroll") for (int k = 0; k < 2; ++k) dst[n][k] = *(const PG8_LAS bf16x8*)(lds + PG8_SB(b, h) + boff + n * 2048 + k * 1024); } while (0)
#define PG8_MMA(ai, bj, At, Bt) do { __builtin_amdgcn_s_setprio(1); _Pragma("unroll") for (int m = 0; m < 4; ++m) _Pragma("unroll") for (int n = 0; n < 2; ++n) _Pragma("unroll") for (int k = 0; k < 2; ++k) \
        acc[ai][bj][m][n] = __builtin_amdgcn_mfma_f32_16x16x32_bf16(Bt[n][k], At[m][k], acc[ai][bj][m][n], 0, 0, 0); __builtin_amdgcn_s_setprio(0); } while (0)
#define PG8_WAIT_V(n) asm volatile("s_waitcnt vmcnt(" #n ")" ::: "memory")
#define PG8_WAIT_L(n) asm volatile("s_waitcnt lgkmcnt(" #n ")" ::: "memory")
#define PG8_BAR __builtin_amdgcn_s_barrier()
#define PG8_SCHED __builtin_amdgcn_sched_barrier(0)
    Unit cur, nxt; int ui = 0;
    if (!S.next(0, cur)) return;
    f32x4 acc[2][2][4][2];
#pragma unroll
    for (int a = 0; a < 2; ++a)
#pragma unroll
        for (int b = 0; b < 2; ++b)
#pragma unroll
            for (int m = 0; m < 4; ++m)
#pragma unroll
                for (int n = 0; n < 2; ++n) acc[a][b][m][n] = (f32x4){0.f, 0.f, 0.f, 0.f};
    bf16x8 At[4][2], B0[2][2], B1[2][2];
    const char* cA = (const char*)g.A + AM::tbase(cur.pm, K); const char* cB = (const char*)g.Bt + (size_t)cur.pn * tstep;
    S.a_ready(cur);
    if constexpr (SP2) {
        PG8_STAGE(PG8_SB(0, 0), cB, voffB); PG8_STAGE(PG8_SB(0, 1), cB + hstep, voffB); PG8_STAGE(PG8_SA(0, 0), cA, voffA); PG8_STAGE(PG8_SA(0, 1), cA + hstepA, voffA);
        if (wr == 1) PG8_BAR;
        PG8_WAIT_V(2); PG8_BAR;
        PG8_STAGE(PG8_SB(1, 0), cB + kstep, voffB); PG8_STAGE(PG8_SA(1, 0), cA + kstep, voffA); PG8_STAGE(PG8_SB(1, 1), cB + hstep + kstep, voffB);
        PG8_WAIT_V(6); PG8_BAR;
    } else {
        PG8_STAGE(PG8_SB(0, 0), cB, voffB); PG8_STAGE(PG8_SA(0, 0), cA, voffA); PG8_STAGE(PG8_SB(0, 1), cB + hstep, voffB); PG8_STAGE(PG8_SA(0, 1), cA + hstepA, voffA);
        if (wr == 1) PG8_BAR;
        PG8_WAIT_V(4); PG8_BAR;
        PG8_STAGE(PG8_SB(1, 0), cB + kstep, voffB); PG8_STAGE(PG8_SA(1, 0), cA + kstep, voffA); PG8_STAGE(PG8_SB(1, 1), cB + hstep + kstep, voffB);
        PG8_WAIT_V(6); PG8_BAR;
    }
    for (;;) {
        const bool has_next = S.next(ui + 1, nxt);
        const char* nA = has_next ? (const char*)g.A + AM::tbase(nxt.pm, K) : cA; const char* nB = has_next ? (const char*)g.Bt + (size_t)nxt.pn * tstep : cB;
        for (int t = 0; t < nt; t += 2) {
            const bool last = (t == nt - 2);
            const char* a1 = cA + (size_t)(t + 1) * kstep;
            const char* a2 = last ? nA : cA + (size_t)(t + 2) * kstep; const char* b2 = last ? nB : cB + (size_t)(t + 2) * kstep;
            const char* a3 = a2 + kstep; const char* b3 = b2 + kstep;
            if (last && has_next) S.a_ready(nxt);
            if constexpr (SP2) {
            PG8_LDB(B0, 0, 0); PG8_LDB(B1, 0, 1); PG8_SCHED; PG8_LDA(At, 0, 0); PG8_STAGE(PG8_SA(1, 1), a1 + hstepA, voffA);
            PG8_WAIT_V(8); PG8_WAIT_L(0); PG8_BAR; PG8_MMA(0, 0, At, B0); PG8_MMA(0, 1, At, B1); PG8_BAR; PG8_SCHED;
            PG8_LDA(At, 0, 1); PG8_STAGE(PG8_SB(0, 0), b2, voffB); PG8_STAGE(PG8_SB(0, 1), b2 + hstep, voffB); PG8_STAGE(PG8_SA(0, 0), a2, voffA);
            PG8_WAIT_V(8); PG8_WAIT_L(0); PG8_BAR; PG8_MMA(1, 0, At, B0); PG8_MMA(1, 1, At, B1); PG8_BAR; PG8_SCHED;
            PG8_LDB(B0, 1, 0); PG8_LDB(B1, 1, 1); PG8_SCHED; PG8_LDA(At, 1, 0); PG8_STAGE(PG8_SA(0, 1), a2 + hstepA, voffA);
            PG8_WAIT_V(8); PG8_WAIT_L(0); PG8_BAR; PG8_MMA(0, 0, At, B0); PG8_MMA(0, 1, At, B1); PG8_BAR; PG8_SCHED;
            PG8_LDA(At, 1, 1); PG8_STAGE(PG8_SB(1, 0), b3, voffB); PG8_STAGE(PG8_SB(1, 1), b3 + hstep, voffB); PG8_STAGE(PG8_SA(1, 0), a3, voffA);
            PG8_WAIT_V(8); PG8_WAIT_L(0); PG8_BAR; PG8_MMA(1, 0, At, B0); PG8_MMA(1, 1, At, B1); PG8_BAR; PG8_SCHED;
            } else {
            PG8_LDB(B0, 0, 0); PG8_SCHED; PG8_LDA(At, 0, 0); PG8_STAGE(PG8_SA(1, 1), a1 + hstepA, voffA);
            PG8_WAIT_L(8); PG8_BAR; PG8_WAIT_L(0); PG8_MMA(0, 0, At, B0); PG8_BAR; PG8_SCHED;
            PG8_LDB(B1, 0, 1); PG8_STAGE(PG8_SB(0, 0), b2, voffB);
            PG8_BAR; PG8_WAIT_L(0); PG8_MMA(0, 1, At, B1); PG8_BAR;
            PG8_LDA(At, 0, 1); PG8_STAGE(PG8_SA(0, 0), a2, voffA);
            PG8_BAR; PG8_WAIT_L(0); PG8_MMA(1, 0, At, B0); PG8_BAR; PG8_SCHED;
            PG8_STAGE(PG8_SB(0, 1), b2 + hstep, voffB);
            PG8_WAIT_V(6); PG8_BAR; PG8_MMA(1, 1, At, B1); PG8_BAR;
            PG8_LDB(B0, 1, 0); PG8_SCHED; PG8_LDA(At, 1, 0); PG8_STAGE(PG8_SA(0, 1), a2 + hstepA, voffA);
            PG8_WAIT_L(8); PG8_BAR; PG8_WAIT_L(0); PG8_MMA(0, 0, At, B0); PG8_BAR; PG8_SCHED;
            PG8_LDB(B1, 1, 1); PG8_STAGE(PG8_SB(1, 0), b3, voffB);
            PG8_BAR; PG8_WAIT_L(0); PG8_MMA(0, 1, At, B1); PG8_BAR;
            PG8_LDA(At, 1, 1); PG8_STAGE(PG8_SA(1, 0), a3, voffA);
            PG8_BAR; PG8_WAIT_L(0); PG8_MMA(1, 0, At, B0); PG8_BAR; PG8_SCHED;
            PG8_STAGE(PG8_SB(1, 1), b3 + hstep, voffB);
            PG8_WAIT_V(6); PG8_BAR; PG8_MMA(1, 1, At, B1); PG8_BAR;
            }
        }
        if constexpr (ALIGN_EPI) { if (wr == 0) PG8_BAR; }
        if constexpr (!Epi::AFTER_DRAIN) { E(acc, cur, wr, wc, fr, fq); S.done(cur); }
        if (!has_next) break;
#pragma unroll
        for (int a = 0; a < 2; ++a)
#pragma unroll
            for (int b = 0; b < 2; ++b)
#pragma unroll
                for (int m = 0; m < 4; ++m)
#pragma unroll
                    for (int n = 0; n < 2; ++n) acc[a][b][m][n] = (f32x4){0.f, 0.f, 0.f, 0.f};
        cur = nxt; cA = nA; cB = nB; ++ui;
        if constexpr (ALIGN_EPI) { if (wr == 1) PG8_BAR; }
    }
    PG8_WAIT_V(0);
    if constexpr (!ALIGN_EPI) { if (wr == 0) PG8_BAR; }
    PG8_BAR;
    if constexpr (Epi::AFTER_DRAIN) { E.fused(acc, cur, wr, wc, fr, fq, lds, wid, lane); S.done(cur); }
#undef PG8_SA
#undef PG8_SB
#undef PG8_STAGE
#undef PG8_LDA
#undef PG8_LDB
#undef PG8_MMA
#undef PG8_WAIT_V
#undef PG8_WAIT_L
#undef PG8_BAR
#undef PG8_SCHED
}
}

namespace {
using pg8::bf16_t; using pg8::bf16x8; using pg8::f32x4; using pg8::u32x4; using pg8::Unit; using pg8::Gemm; using pg8::StaticOrder; using pg8::cvt_pk_bf16;
#define GAS __attribute__((address_space(1)))
#define LAS __attribute__((address_space(3)))
typedef unsigned v2u __attribute__((ext_vector_type(2)));
typedef float f32x16 __attribute__((ext_vector_type(16)));

constexpr int D = 1024, NB = 4, SEQ = 8192, TL = NB * SEQ  , CTXL = 256, TC = NB * CTXL  , TT = TL + TC  ;
constexpr int DEPTH = 4, NH = 4, DK = 128, DV = 256, CHUNK = 64, DFF = 2816, APROJ = 3088, MODW = 6 * D;
constexpr float EPS = 1e-6f;
constexpr int NWAVES = 8, NTHR = 512;

constexpr size_t MiB = 1u << 20;
constexpr size_t WS_CTL = 0, CTL_ZERO_BYTES = 2 * MiB;
constexpr int CW_BAR = 4096;
constexpr size_t WS_MOD = 1 * MiB;
constexpr size_t WS_GATES = 2 * MiB;
constexpr size_t WS_GM = 5 * MiB;
constexpr size_t WS_NST = 5 * MiB + 65536;
constexpr size_t WS_CTXRES = 7 * MiB;
constexpr size_t WS_W = 11 * MiB;
constexpr size_t W_AING = 12 * MiB;
constexpr size_t W_AIN = 0, W_AOUT = 16 * MiB, W_BIN = 20 * MiB, W_BOUT = 32 * MiB, W_UP = 36 * MiB, W_DN = 80 * MiB;
constexpr size_t WS_HX = 113 * MiB;
constexpr size_t WS_BIG = 179 * MiB;
constexpr size_t BIG_Q = 0, BIG_O = 33 * MiB, BIG_K = 99 * MiB, BIG_VT = 132 * MiB, BIG_UC = 198 * MiB;
constexpr size_t BIG_CU = 0, BIG_Z = 66 * MiB, BIG_PC = 132 * MiB;
constexpr size_t BIG_XF = 198 * MiB;
constexpr size_t BIG_CPART = 282 * MiB;
constexpr size_t BIG_A = 0, BIG_GV = 182 * MiB, BIG_GVC = 270 * MiB;
constexpr size_t WS_MODP = WS_BIG;
constexpr size_t WS_END = 509 * MiB;

constexpr int LDS_BYTES = 147456;
constexpr int MISC_OFF = LDS_BYTES - 256;

__device__ __forceinline__ float bf2f(unsigned short b) { return __uint_as_float(((unsigned)b) << 16); }
__device__ __forceinline__ float bflo(unsigned w) { return __uint_as_float(w << 16); }
__device__ __forceinline__ float bfhi(unsigned w) { return __uint_as_float(w & 0xffff0000u); }
__device__ __forceinline__ unsigned f2bf(float f) { unsigned u = __float_as_uint(f); return (u + 0x7fffu + ((u >> 16) & 1u)) >> 16; }
__device__ __forceinline__ float bfround(float f) { return __uint_as_float(f2bf(f) << 16); }
typedef __bf16 bf16v2_t __attribute__((ext_vector_type(2)));
__device__ __forceinline__ unsigned pk2(float lo, float hi) { bf16v2_t t; t.x = (__bf16)lo; t.y = (__bf16)hi; return __builtin_bit_cast(unsigned, t); }
__device__ __forceinline__ float wave_sum(float v) {
#pragma unroll
    for (int o = 1; o < 64; o <<= 1) v += __shfl_xor(v, o);
    return v;
}
__device__ __forceinline__ float wave_max(float v) {
#pragma unroll
    for (int o = 1; o < 64; o <<= 1) v = fmaxf(v, __shfl_xor(v, o));
    return v;
}
__device__ __forceinline__ float prefix_sum64(float x, int lane) {
#pragma unroll
    for (int o = 1; o < 64; o <<= 1) { const float y = __shfl_up(x, o); if (lane >= o) x += y; }
    return x;
}
__device__ __forceinline__ float prefix_max64(float x, int lane) {
#pragma unroll
    for (int o = 1; o < 64; o <<= 1) { const float y = __shfl_up(x, o); if (lane >= o) x = fmaxf(x, y); }
    return x;
}
__device__ __forceinline__ void lds_add(LAS float* p, float v) { (void)__hip_atomic_fetch_add(p, v, __ATOMIC_RELAXED, __HIP_MEMORY_SCOPE_WORKGROUP); }
__device__ __forceinline__ float sigmoidf_(float x) { return __builtin_amdgcn_rcpf(1.0f + __expf(-x)); }
__device__ __forceinline__ float siluf_(float x) { return x * __builtin_amdgcn_rcpf(1.0f + __expf(-x)); }
__device__ __forceinline__ float logsigmoidf_(float x) { const float y = __expf(-fabsf(x)); const float l = y < 0.0625f ? y * (1.0f - y * (0.5f - y * (0.33333334f - y * (0.25f - 0.2f * y)))) : __logf(1.0f + y); return fminf(x, 0.f) - l; }

__device__ __forceinline__ void unpack8(const u32x4 w, float (&f)[8]) { f[0] = bflo(w.x); f[1] = bfhi(w.x); f[2] = bflo(w.y); f[3] = bfhi(w.y); f[4] = bflo(w.z); f[5] = bfhi(w.z); f[6] = bflo(w.w); f[7] = bfhi(w.w); }

#define XB_TMO      128
#define XB_XCNT(j)  (256  + 64 * (j))
#define XB_XSUB(j)  (1280 + 64 * (j))
#define XB_XGEN(j)  (2304 + 64 * (j))
#define XB_TOP      3328
#define XB_TOPGEN   3392
#define XCD_BAR_WORDS 3456
#define XB_SPIN_CAP (1u << 18)
__device__ __forceinline__ unsigned xb_ld(unsigned* p)              { return __hip_atomic_load(p, __ATOMIC_RELAXED, __HIP_MEMORY_SCOPE_AGENT); }
__device__ __forceinline__ unsigned xb_add(unsigned* p, unsigned v) { return __hip_atomic_fetch_add(p, v, __ATOMIC_RELAXED, __HIP_MEMORY_SCOPE_AGENT); }
__device__ __forceinline__ unsigned xb_xcc_id() { return (unsigned)__builtin_amdgcn_s_getreg((3 << 11) | 20) & 0xFu; }
#define XB_SPIN(cond, bar) do { unsigned _sp = 0; while (cond) { __builtin_amdgcn_s_sleep(1); \
    if ((++_sp & 255u) == 0u) { if (xb_ld(&(bar)[XB_TMO])) break; if (_sp > XB_SPIN_CAP) { atomicAdd(&(bar)[XB_TMO], 1u); break; } } } } while (0)
struct XcdBarrier { unsigned* bar; unsigned x; volatile LAS unsigned* st; };
__device__ __forceinline__ XcdBarrier xcd_barrier_post(unsigned* bar, volatile LAS unsigned* st) {
    XcdBarrier b; b.bar = bar; b.x = xb_xcc_id(); b.st = st;
    if (threadIdx.x == 0) (void)xb_add(&bar[XB_XCNT(b.x)], 1u);
    return b;
}
__device__ __forceinline__ void xcd_barrier_complete(unsigned* bar, unsigned x, unsigned& nloc, unsigned& nx) {
    const unsigned G = gridDim.x * gridDim.y * gridDim.z;
    unsigned sum, cnt, mine, sp = 0u;
    for (;;) {
        sum = 0u; cnt = 0u; mine = 0u;
#pragma unroll
        for (unsigned j = 0; j < 16; ++j) { const unsigned c = xb_ld(&bar[XB_XCNT(j)]); sum += c; cnt += (c > 0u) ? 1u : 0u; mine = (j == x) ? c : mine; }
        if (sum == G) break;
        __builtin_amdgcn_s_sleep(1);
        if ((++sp & 255u) == 0u) { if (xb_ld(&bar[XB_TMO])) break; if (sp > XB_SPIN_CAP) { atomicAdd(&bar[XB_TMO], 1u); break; } }
    }
    nloc = mine > 0u ? mine : 1u; nx = cnt > 0u ? cnt : 1u;
}
__device__ __forceinline__ void xcd_barrier(const XcdBarrier& b) {
    asm volatile("s_waitcnt vmcnt(0)" ::: "memory");
    __syncthreads();
    if (threadIdx.x == 0) {
        unsigned* bar = b.bar;
        __builtin_amdgcn_s_waitcnt(0);
        unsigned nloc = b.st[0], nx = b.st[1];
        if (nloc == 0u) { xcd_barrier_complete(bar, b.x, nloc, nx); b.st[0] = nloc; b.st[1] = nx; }
        const unsigned old = xb_add(&bar[XB_XSUB(b.x)], 1u);
        const unsigned gen = old / nloc;
        if (old + 1u == (gen + 1u) * nloc) {
            __builtin_amdgcn_fence(__ATOMIC_RELEASE, "agent");
            asm volatile("s_waitcnt vmcnt(0)" ::: "memory");
            const unsigned og = xb_add(&bar[XB_TOP], 1u);
            const unsigned tg = og / nx;
            if (og + 1u == (tg + 1u) * nx) xb_add(&bar[XB_TOPGEN], 1u);
            else XB_SPIN(xb_ld(&bar[XB_TOPGEN]) == tg, bar);
            __builtin_amdgcn_fence(__ATOMIC_ACQUIRE, "agent");
            xb_add(&bar[XB_XGEN(b.x)], 1u);
            asm volatile("s_waitcnt vmcnt(0)" ::: "memory");
        } else {
            XB_SPIN(xb_ld(&bar[XB_XGEN(b.x)]) == gen, bar);
            __builtin_amdgcn_fence(__ATOMIC_ACQUIRE, "agent");
            asm volatile("s_waitcnt vmcnt(0)" ::: "memory");
        }
    }
    __syncthreads();
}

struct EpiStoreBf16 {
    static constexpr bool PERM = true, AFTER_DRAIN = false;
    bf16_t* O; int ldc; int split_cols; size_t split_stride;
    __device__ __forceinline__ void operator()(const f32x4 (&acc)[2][2][4][2], const Unit& u, int wr, int wc, int fr, int fq) const {
        const int row0 = u.pm * 256 + wr * 64 + fr; int colt = u.pn * 256; bf16_t* base = O;
        if (split_cols) { const int t = colt / split_cols; base += (size_t)t * split_stride; colt -= t * split_cols; }
        const int col0 = colt + wc * 32 + 8 * fq;
#pragma unroll
        for (int ai = 0; ai < 2; ++ai)
#pragma unroll
            for (int m = 0; m < 4; ++m) { bf16_t* rowp = base + (size_t)(row0 + ai * 128 + m * 16) * ldc + col0;
#pragma unroll
                for (int bj = 0; bj < 2; ++bj) { const f32x4 v0 = acc[ai][bj][m][0], v1 = acc[ai][bj][m][1];
                    u32x4 w; w.x = cvt_pk_bf16(v0[0], v0[1]); w.y = cvt_pk_bf16(v0[2], v0[3]); w.z = cvt_pk_bf16(v1[0], v1[1]); w.w = cvt_pk_bf16(v1[2], v1[3]);
                    *(u32x4*)(rowp + bj * 128) = w; } }
    }
};
struct EpiQOK {
    static constexpr bool PERM = true, AFTER_DRAIN = false;
    bf16_t *Q, *O, *K; int row_off;
    __device__ __forceinline__ void operator()(const f32x4 (&acc)[2][2][4][2], const Unit& u, int wr, int wc, int fr, int fq) const {
        bf16_t* base; int ldc, colt;
        if (u.pn < 2) { base = Q; ldc = 512; colt = u.pn * 256; } else if (u.pn < 6) { base = O; ldc = 1024; colt = (u.pn - 2) * 256; } else { base = K; ldc = 512; colt = (u.pn - 6) * 256; }
        const int row0 = row_off + u.pm * 256 + wr * 64 + fr, col0 = colt + wc * 32 + 8 * fq;
#pragma unroll
        for (int ai = 0; ai < 2; ++ai)
#pragma unroll
            for (int m = 0; m < 4; ++m) { bf16_t* rowp = base + (size_t)(row0 + ai * 128 + m * 16) * ldc + col0;
#pragma unroll
                for (int bj = 0; bj < 2; ++bj) { const f32x4 v0 = acc[ai][bj][m][0], v1 = acc[ai][bj][m][1];
                    u32x4 w; w.x = cvt_pk_bf16(v0[0], v0[1]); w.y = cvt_pk_bf16(v0[2], v0[3]); w.z = cvt_pk_bf16(v1[0], v1[1]); w.w = cvt_pk_bf16(v1[2], v1[3]);
                    *(u32x4*)(rowp + bj * 128) = w; } }
    }
};
struct ColStripA {
    static __device__ __forceinline__ unsigned voff(int R, int C, int K) { return (unsigned)(((8 * (R & 15) + ((R >> 4) & 3)) * 64 + (R >> 6)) * K + C) * 2u; }
    static __device__ __forceinline__ size_t hstep(int K) { return (size_t)256 * K * 2; }
    static __device__ __forceinline__ size_t tbase(int pm, int K) { return (size_t)((pm >> 5) * SEQ + 2 * (pm & 31)) * K * 2; }
};
__device__ __forceinline__ f32x4 dpp_prev(const f32x4 x) { f32x4 r;
#pragma unroll
    for (int j = 0; j < 4; ++j) r[j] = __int_as_float(__builtin_amdgcn_update_dpp(0, __float_as_int(x[j]), 0x111, 0xf, 0xf, true));
    return r; }
__device__ __forceinline__ f32x4 dpp_next(const f32x4 x) { f32x4 r;
#pragma unroll
    for (int j = 0; j < 4; ++j) r[j] = __int_as_float(__builtin_amdgcn_update_dpp(0, __float_as_int(x[j]), 0x101, 0xf, 0xf, true));
    return r; }
struct EpiConvGLU {
    static constexpr bool PERM = true, AFTER_DRAIN = false;
    bf16_t* Aout; const float* wconv  ; const float* bconv  ;
    __device__ __forceinline__ void operator()(const f32x4 (&acc)[2][2][4][2], const Unit& u, int wr, int wc, int fr, int fq) const {
        const int ch0 = u.pn * 128 + wc * 32 + 8 * fq;
        const size_t tok0 = (size_t)(u.pm >> 5) * SEQ + 2 * (u.pm & 31) + wr;
        f32x4 w0[2], w1[2], w2[2], bb[2];
#pragma unroll
        for (int n = 0; n < 2; ++n) { w0[n] = *(const f32x4*)(wconv + ch0 + 4 * n); w1[n] = *(const f32x4*)(wconv + DFF + ch0 + 4 * n); w2[n] = *(const f32x4*)(wconv + 2 * DFF + ch0 + 4 * n); bb[n] = *(const f32x4*)(bconv + ch0 + 4 * n); }
#pragma unroll
        for (int s = 0; s < 8; ++s) {
            const int ai = s >> 2, m = s & 3;
            u32x4 w;
#pragma unroll
            for (int n = 0; n < 2; ++n) {
                const f32x4 gp = s > 0 ? acc[(s - 1) >> 2][0][(s - 1) & 3][n] : dpp_prev(acc[1][0][3][n]);
                const f32x4 gn = s < 7 ? acc[(s + 1) >> 2][0][(s + 1) & 3][n] : dpp_next(acc[0][0][0][n]);
                const f32x4 t = w0[n] * gp + w1[n] * acc[ai][0][m][n] + w2[n] * gn + bb[n];
                f32x4 o;
#pragma unroll
                for (int j = 0; j < 4; ++j) o[j] = siluf_(t[j]) * acc[ai][1][m][n][j];
                if (n == 0) { w.x = pk2(o[0], o[1]); w.y = pk2(o[2], o[3]); } else { w.z = pk2(o[0], o[1]); w.w = pk2(o[2], o[3]); }
            }
            *(u32x4*)(Aout + (tok0 + (size_t)(8 * fr + s) * 64) * DFF + ch0) = w;
        }
    }
};
struct SeqStripA {
    static __device__ __forceinline__ unsigned voff(int R, int C, int K) { return (unsigned)((128 * (R >> 6) + 8 * (R & 15) + ((R >> 4) & 3)) * K + C) * 2u; }
    static __device__ __forceinline__ size_t hstep(int K) { return (size_t)4 * K * 2; }
    static __device__ __forceinline__ size_t tbase(int pm, int K) { return (size_t)pm * 256 * K * 2; }
};
struct EpiConvU {
    static constexpr bool PERM = true, AFTER_DRAIN = false;
    bf16_t* CU; const float* wconv  ;
    __device__ __forceinline__ void operator()(const f32x4 (&acc)[2][2][4][2], const Unit& u, int wr, int wc, int fr, int fq) const {
        const int ch0 = u.pn * 128 + wc * 32 + 8 * fq;
        const size_t tok0 = (size_t)u.pm * 256 + 128 * wr + 8 * fr;
        const bool first = (fr & 7) == 0, last = (fr & 7) == 7;
        f32x4 w0[2], w1[2], w2[2];
#pragma unroll
        for (int n = 0; n < 2; ++n) { w0[n] = *(const f32x4*)(wconv + ch0 + 4 * n); w1[n] = *(const f32x4*)(wconv + D + ch0 + 4 * n); w2[n] = *(const f32x4*)(wconv + 2 * D + ch0 + 4 * n); }
        f32x4 pv[2], nx[2];
#pragma unroll
        for (int n = 0; n < 2; ++n) { pv[n] = dpp_prev(acc[1][0][3][n] * acc[1][1][3][n]); nx[n] = dpp_next(acc[0][0][0][n] * acc[0][1][0][n]);
            if (first) pv[n] = (f32x4){0.f, 0.f, 0.f, 0.f}; if (last) nx[n] = (f32x4){0.f, 0.f, 0.f, 0.f}; }
#pragma unroll
        for (int s = 0; s < 8; ++s) {
            u32x4 w;
#pragma unroll
            for (int n = 0; n < 2; ++n) {
                const f32x4 up = s > 0 ? acc[(s - 1) >> 2][0][(s - 1) & 3][n] * acc[(s - 1) >> 2][1][(s - 1) & 3][n] : pv[n];
                const f32x4 un = s < 7 ? acc[(s + 1) >> 2][0][(s + 1) & 3][n] * acc[(s + 1) >> 2][1][(s + 1) & 3][n] : nx[n];
                const f32x4 o = w0[n] * up + w1[n] * (acc[s >> 2][0][s & 3][n] * acc[s >> 2][1][s & 3][n]) + w2[n] * un;
                if (n == 0) { w.x = pk2(o[0], o[1]); w.y = pk2(o[2], o[3]); } else { w.z = pk2(o[0], o[1]); w.w = pk2(o[2], o[3]); }
            }
            *(u32x4*)(CU + (tok0 + s) * D + ch0) = w;
        }
    }
};
struct EpiMulZ {
    static constexpr bool PERM = true, AFTER_DRAIN = false;
    const bf16_t* CU; bf16_t* Z;
    __device__ __forceinline__ void operator()(const f32x4 (&acc)[2][2][4][2], const Unit& u, int wr, int wc, int fr, int fq) const {
        const int row0 = u.pm * 256 + wr * 64 + fr, col0 = u.pn * 256 + wc * 32 + 8 * fq;
        u32x4 cur[2], nxt[2];
#pragma unroll
        for (int bj = 0; bj < 2; ++bj) cur[bj] = *(const u32x4*)(CU + (size_t)row0 * D + col0 + bj * 128);
#pragma unroll
        for (int g = 0; g < 8; ++g) { const int ai = g >> 2, m = g & 3; const size_t off = (size_t)(row0 + ai * 128 + m * 16) * D + col0;
            if (g < 7) { const size_t offn = (size_t)(row0 + ((g + 1) >> 2) * 128 + ((g + 1) & 3) * 16) * D + col0;
#pragma unroll
                for (int bj = 0; bj < 2; ++bj) nxt[bj] = *(const u32x4*)(CU + offn + bj * 128); }
#pragma unroll
            for (int bj = 0; bj < 2; ++bj) { float c[8]; unpack8(cur[bj], c); const f32x4 v0 = acc[ai][bj][m][0], v1 = acc[ai][bj][m][1];
                u32x4 w; w.x = pk2(v0[0] * c[0], v0[1] * c[1]); w.y = pk2(v0[2] * c[2], v0[3] * c[3]); w.z = pk2(v1[0] * c[4], v1[1] * c[5]); w.w = pk2(v1[2] * c[6], v1[3] * c[7]);
                *(u32x4*)(Z + off + bj * 128) = w; cur[bj] = nxt[bj]; }
        }
    }
};
template <bool BASEF32, bool OUTBF> struct EpiResidual {
    static constexpr bool PERM = true, AFTER_DRAIN = false;
    const void* base; void* out; const float* gate0; int gdiv;
    __device__ __forceinline__ void ldb(size_t off, f32x4 (&d)[2][2]) const {
        if (BASEF32) {
#pragma unroll
            for (int bj = 0; bj < 2; ++bj)
#pragma unroll
                for (int n = 0; n < 2; ++n) d[bj][n] = *(const f32x4*)((const float*)base + off + bj * 128 + n * 4);
        } else {
#pragma unroll
            for (int bj = 0; bj < 2; ++bj) { const u32x4 w = *(const u32x4*)((const bf16_t*)base + off + bj * 128);
                d[bj][0] = (f32x4){bflo(w.x), bfhi(w.x), bflo(w.y), bfhi(w.y)}; d[bj][1] = (f32x4){bflo(w.z), bfhi(w.z), bflo(w.w), bfhi(w.w)}; }
        }
    }
    __device__ __forceinline__ void operator()(const f32x4 (&acc)[2][2][4][2], const Unit& u, int wr, int wc, int fr, int fq) const {
        const int row0 = u.pm * 256 + wr * 64 + fr, col0 = u.pn * 256 + wc * 32 + 8 * fq;
        const float* gp = gate0 + (size_t)(u.pm / gdiv) * MODW + col0;
        f32x4 gv[2][2], cur[2][2], nxt[2][2];
#pragma unroll
        for (int bj = 0; bj < 2; ++bj)
#pragma unroll
            for (int n = 0; n < 2; ++n) gv[bj][n] = *(const f32x4*)(gp + bj * 128 + n * 4);
        ldb((size_t)row0 * D + col0, cur);
#pragma unroll
        for (int g = 0; g < 8; ++g) { const int ai = g >> 2, m = g & 3; const size_t off = (size_t)(row0 + ai * 128 + m * 16) * D + col0;
            if (g < 7) ldb((size_t)(row0 + ((g + 1) >> 2) * 128 + ((g + 1) & 3) * 16) * D + col0, nxt);
#pragma unroll
            for (int bj = 0; bj < 2; ++bj) { f32x4 x[2];
#pragma unroll
                for (int n = 0; n < 2; ++n) { x[n] = cur[bj][n] + gv[bj][n] * acc[ai][bj][m][n]; cur[bj][n] = nxt[bj][n]; }
                if (OUTBF) { u32x4 w; w.x = pk2(x[0][0], x[0][1]); w.y = pk2(x[0][2], x[0][3]); w.z = pk2(x[1][0], x[1][1]); w.w = pk2(x[1][2], x[1][3]); *(u32x4*)((bf16_t*)out + off + bj * 128) = w; }
                else { *(f32x4*)((float*)out + off + bj * 128) = x[0]; *(f32x4*)((float*)out + off + bj * 128 + 4) = x[1]; } }
        }
    }
};

template <class Epi, class AM = pg8::NatA>
__device__ __forceinline__ void run_gemm(LAS unsigned char* lds, const bf16_t* A, const bf16_t* Bt, int M, int N, int K, const Epi& E, int boff = 0) {
    Gemm g{A, Bt, M, N, K}; StaticOrder S; const int G = (int)gridDim.x; S.init(M, N, G, ((int)blockIdx.x + G - boff) % G);
    pg8::gemm_phase<Epi, StaticOrder, true, true, AM>(lds, g, S, E);
}

template <class Epi>
__device__ __forceinline__ void run_gemm_slice(LAS unsigned char* lds, const bf16_t* A, const bf16_t* Bt, int M, int N, int k0, int Ks, int ld, int boff, const Epi& E) {
    Gemm g{A + k0, Bt + k0, M, N, Ks, ld}; StaticOrder S; const int G = (int)gridDim.x; S.init(M, N, G, ((int)blockIdx.x + G - boff) % G);
    pg8::gemm_phase<Epi, StaticOrder, true, true>(lds, g, S, E);
}
struct EpiPartF32 {
    static constexpr bool PERM = false, AFTER_DRAIN = false;
    float* Pout;
    __device__ __forceinline__ void operator()(const f32x4 (&acc)[2][2][4][2], const Unit& u, int wr, int wc, int fr, int fq) const {
        const int row0 = u.pm * 256 + wr * 64 + fr, col0 = u.pn * 256 + wc * 32 + 4 * fq;
#pragma unroll
        for (int ai = 0; ai < 2; ++ai)
#pragma unroll
            for (int m = 0; m < 4; ++m) { float* rp = Pout + (size_t)(row0 + ai * 128 + m * 16) * D + col0;
#pragma unroll
                for (int bj = 0; bj < 2; ++bj)
#pragma unroll
                    for (int n = 0; n < 2; ++n) *(f32x4*)(rp + bj * 128 + n * 16) = acc[ai][bj][m][n]; }
    }
};
struct EpiVT {
    static constexpr bool PERM = true, AFTER_DRAIN = false;
    bf16_t* VT; int tok0;
    __device__ __forceinline__ void operator()(const f32x4 (&acc)[2][2][4][2], const Unit& u, int wr, int wc, int fr, int fq) const {
        const int f0 = u.pm * 256 + wr * 64 + fr, r0 = tok0 + u.pn * 256 + wc * 32 + 8 * fq;
#pragma unroll
        for (int ai = 0; ai < 2; ++ai)
#pragma unroll
            for (int m = 0; m < 4; ++m) { const int f = f0 + ai * 128 + m * 16, h = f >> 8, vb = (f & 255) >> 5, vl = f & 31;
#pragma unroll
                for (int bj = 0; bj < 2; ++bj) { const int r = r0 + bj * 128, tb = r >> 7, ks = (r & 127) >> 4, hh = (r >> 3) & 1;
                    const f32x4 v0 = acc[ai][bj][m][0], v1 = acc[ai][bj][m][1];
                    u32x4 w; w.x = cvt_pk_bf16(v0[0], v0[1]); w.y = cvt_pk_bf16(v0[2], v0[3]); w.z = cvt_pk_bf16(v1[0], v1[1]); w.w = cvt_pk_bf16(v1[2], v1[3]);
                    *(u32x4*)(VT + ((size_t)((((tb * 4 + h) * 8 + vb) * 8 + ks) * 2 + hh) * 32 + vl) * 8) = w; } }
    }
};
struct EpiGates {
    static constexpr bool PERM = false, AFTER_DRAIN = false;
    float* GT; const float* bgate; int row0;
    __device__ __forceinline__ void operator()(const f32x4 (&acc)[2][2][4][2], const Unit& u, int wr, int wc, int fr, int fq) const {
        if (wc != 0) return;
        const int r0 = row0 + u.pm * 256 + wr * 64 + fr;
        const f32x4 bg = *(const f32x4*)(bgate + 4 * fq);
#pragma unroll
        for (int ai = 0; ai < 2; ++ai)
#pragma unroll
            for (int m = 0; m < 4; ++m) { const int row = r0 + ai * 128 + m * 16; const f32x4 a = acc[ai][0][m][0] + acc[ai][0][m][1] + bg;
#pragma unroll
                for (int j = 0; j < 4; ++j) GT[(size_t)(4 * fq + j) * TT + row] = fq < 2 ? a[j] : logsigmoidf_(a[j]); }
    }
};

__device__ __forceinline__ void transpose_item(const float* W, int ld, int K, int k0, int n0src, bf16_t* WT, int row0dst, float scale, LAS float* scr, int lane) {
#pragma unroll 8
    for (int i = 0; i < 32; ++i) { const int kk = 2 * i + (lane >> 5); scr[kk * 33 + (lane & 31)] = W[(size_t)(k0 + kk) * ld + n0src + (lane & 31)] * scale; }
    asm volatile("s_waitcnt lgkmcnt(0)" ::: "memory");
    const int c = lane & 7;
#pragma unroll
    for (int j = 0; j < 4; ++j) { const int n = (lane >> 3) + 8 * j; const LAS float* s = scr + (8 * c) * 33 + n;
        u32x4 o; o.x = pk2(s[0 * 33], s[1 * 33]); o.y = pk2(s[2 * 33], s[3 * 33]); o.z = pk2(s[4 * 33], s[5 * 33]); o.w = pk2(s[6 * 33], s[7 * 33]);
        *(u32x4*)(WT + (size_t)(row0dst + n) * K + k0 + 8 * c) = o; }
    asm volatile("s_waitcnt lgkmcnt(0)" ::: "memory");
}
struct Ptrs {
    const float *x, *c, *ctx, *c_ctx, *w_mod, *b_mod, *g_mix, *g_ffn, *a_w_in, *a_b_gate, *a_head_gain, *a_w_out, *b_w_in, *b_w_conv, *b_w_out, *f_w_up, *f_w_conv, *f_b_conv, *f_w_down, *g_final;
    float* out; unsigned char* ws;
};
__device__ __forceinline__ void p0_convert(const Ptrs& P, LAS unsigned char* lds, int wave, int lane) {
    LAS float* scr = (LAS float*)(lds + wave * 16384);
    const int gw = blockIdx.x * NWAVES + wave, NGW = gridDim.x * NWAVES;
    constexpr int I_AIN = 16 * 96, I_AOUT = 16 * 32, I_BIN = 16 * 96, I_BOUT = 16 * 32, I_UP = 16 * 176, I_DN = 44 * 32;
    constexpr int S0 = 2 * I_AIN, S1 = S0 + 2 * I_AOUT, S2 = S1 + 2 * I_BIN, S3 = S2 + 2 * I_BOUT, S4 = S3 + 4 * I_UP, S5 = S4 + 4 * I_DN;
    bf16_t* WB = (bf16_t*)(P.ws + WS_W);
    for (int it = gw; it < S5; it += NGW) {
        if (it < S0) { const int j = it / I_AIN, r = it % I_AIN, kb = r / 96, ng = r % 96;
            const int drow = ng < 16 ? 32 * ng : ng < 32 ? 1536 + 32 * (ng - 16) : ng < 64 ? 2048 + 32 * (ng - 32) : 512 + 32 * (ng - 64);
            transpose_item(P.a_w_in + (size_t)j * D * APROJ, APROJ, D, 64 * kb, 32 * ng, WB + (W_AIN / 2) + (size_t)j * 3072 * D, drow, (ng >= 16 && ng < 32) ? 0.08838834764831845f : 1.0f, scr, lane);
        } else if (it < S1) { const int q = it - S0, j = q / I_AOUT, r = q % I_AOUT, kb = r / 32, ng = r % 32;
            transpose_item(P.a_w_out + (size_t)j * D * D, D, D, 64 * kb, 32 * ng, WB + (W_AOUT / 2) + (size_t)j * D * D, 32 * ng, 1.0f, scr, lane);
        } else if (it < S2) { const int q = it - S1, j = q / I_BIN, r = q % I_BIN, kb = r / 96, ng = r % 96;
            const int c0 = 32 * (ng & 31), drow = ng < 32 ? 2048 + c0 : 256 * (c0 >> 7) + (c0 & 127) + (ng < 64 ? 0 : 128);
            transpose_item(P.b_w_in + (size_t)j * D * 3 * D, 3 * D, D, 64 * kb, 32 * ng, WB + (W_BIN / 2) + (size_t)j * 3 * D * D, drow, 1.0f, scr, lane);
        } else if (it < S3) { const int q = it - S2, j = q / I_BOUT, r = q % I_BOUT, kb = r / 32, ng = r % 32;
            transpose_item(P.b_w_out + (size_t)j * D * D, D, D, 64 * kb, 32 * ng, WB + (W_BOUT / 2) + (size_t)j * D * D, 32 * ng, 1.0f, scr, lane);
        } else if (it < S4) { const int q = it - S3, i = q / I_UP, r = q % I_UP, kb = r / 176, ng = r % 176;
            const int c0 = 32 * (ng < 88 ? ng : ng - 88), drow = 256 * (c0 >> 7) + (c0 & 127) + (ng < 88 ? 0 : 128);
            transpose_item(P.f_w_up + (size_t)i * D * 2 * DFF, 2 * DFF, D, 64 * kb, 32 * ng, WB + (W_UP / 2) + (size_t)i * 2 * DFF * D, drow, 1.0f, scr, lane);
        } else { const int q = it - S4, i = q / I_DN, r = q % I_DN, kb = r / 32, ng = r % 32;
            transpose_item(P.f_w_down + (size_t)i * DFF * D, D, DFF, 64 * kb, 32 * ng, WB + (W_DN / 2) + (size_t)i * D * DFF, 32 * ng, 1.0f, scr, lane);
        }
    }
}
__device__ __forceinline__ void p0_mod(const Ptrs& P, LAS unsigned char* lds, int tid) {
    LAS float* s = (LAS float*)lds;
    for (int i = tid; i < 5 * D; i += NTHR) { const int b = i >> 10, k = i & 1023; const float v = b < 4 ? P.c[b * D + k] : P.c_ctx[k]; s[i] = v / (1.0f + __expf(-v)); }
    __syncthreads();
    float* MODP = (float*)(P.ws + WS_MODP);
    for (int u = blockIdx.x; u < DEPTH * 16 * 12; u += gridDim.x) {
        const int i = u / 192, r = u % 192, ks = r / 12, nb = r % 12, n = nb * 512 + tid;
        const float* w = P.w_mod + ((size_t)i * D + 64 * ks) * MODW + n;
        float a0 = 0.f, a1 = 0.f, a2 = 0.f, a3 = 0.f, a4 = 0.f;
#pragma unroll 8
        for (int k = 0; k < 64; ++k) { const float wv = w[(size_t)k * MODW]; const int kk = 64 * ks + k;
            a0 += s[kk] * wv; a1 += s[D + kk] * wv; a2 += s[2 * D + kk] * wv; a3 += s[3 * D + kk] * wv; a4 += s[4 * D + kk] * wv; }
        float* o = MODP + ((size_t)ks * DEPTH + i) * 5 * MODW + n;
        o[0] = a0; o[MODW] = a1; o[2 * MODW] = a2; o[3 * MODW] = a3; o[4 * MODW] = a4;
    }
}
__device__ __forceinline__ void mod_reduce(const Ptrs& P, int tid) {
    const float* MODP = (const float*)(P.ws + WS_MODP); float* MOD = (float*)(P.ws + WS_MOD);
    for (int e = blockIdx.x * NTHR + tid; e < DEPTH * 5 * MODW; e += gridDim.x * NTHR) {
        const int i = e / (5 * MODW), n = e % MODW; float a = P.b_mod[i * MODW + n];
#pragma unroll
        for (int ks = 0; ks < 16; ++ks) a += MODP[(size_t)ks * DEPTH * 5 * MODW + e];
        MOD[e] = a;
    }
}
#define NC0(j) (512 * ((j) >> 1) + 8 * lane + 4 * ((j) & 1))
template <bool GATES, bool BF16IN>
__device__ __forceinline__ void norm_phase(const float* xl, const float* xc, float* xco, const float* cpart, int ncp, const float* cgate, int nrows, const float* g, const float* modl  , int sh_off, int sc_off, bf16_t* HX,
                                           const float* wg  , const float* bgate, float* GT, LAS unsigned char* lds, int tid, int wave, int lane) {
    LAS float* wl = (LAS float*)lds;
    if (GATES) { for (int i = tid; i < 16 * D; i += NTHR) { const int k = i >> 4, gi = i & 15; wl[gi * D + k] = wg[(size_t)k * APROJ + gi]; } __syncthreads(); }
    const int gw = blockIdx.x * NWAVES + wave, NGW = gridDim.x * NWAVES;
    const int RPW = (TL + NGW - 1) / NGW, r0 = gw * RPW, nl = r0 < TL ? (TL - r0 < RPW ? TL - r0 : RPW) : 0;
    int bcur = -1; f32x4 gsv[4], shv[4];
    int idx0 = 0;
    if (!GATES && BF16IN) {
        for (; idx0 + 4 <= nl; idx0 += 4) {
            const int row = r0 + idx0, b = row >> 13;
            if (b != bcur) { bcur = b; const float* mb = modl + (size_t)b * MODW;
#pragma unroll
                for (int j = 0; j < 4; ++j) { const int c0 = NC0(j); gsv[j] = *(const f32x4*)(g + c0) * (*(const f32x4*)(mb + sc_off + c0) + 1.0f); shv[j] = *(const f32x4*)(mb + sh_off + c0); } }
            const bf16_t* xbr = (const bf16_t*)xl + (size_t)row * D;
            u32x4 w[4][2];
#pragma unroll
            for (int r = 0; r < 4; ++r)
#pragma unroll
                for (int jj = 0; jj < 2; ++jj) w[r][jj] = *(const u32x4*)(xbr + (size_t)r * D + NC0(2 * jj));
            asm volatile("" ::: "memory");
#pragma unroll
            for (int r = 0; r < 4; ++r) {
                f32x4 v[4]; float ss = 0.f;
#pragma unroll
                for (int jj = 0; jj < 2; ++jj) { const u32x4 q = w[r][jj]; v[2 * jj] = (f32x4){bflo(q.x), bfhi(q.x), bflo(q.y), bfhi(q.y)}; v[2 * jj + 1] = (f32x4){bflo(q.z), bfhi(q.z), bflo(q.w), bfhi(q.w)}; }
#pragma unroll
                for (int j = 0; j < 4; ++j) ss += (v[j][0] * v[j][0] + v[j][1] * v[j][1]) + (v[j][2] * v[j][2] + v[j][3] * v[j][3]);
                const float rstd = rsqrtf(wave_sum(ss) * (1.0f / D) + EPS);
#pragma unroll
                for (int j = 0; j < 4; ++j) v[j] = (v[j] * rstd) * gsv[j] + shv[j];
#pragma unroll
                for (int jj = 0; jj < 2; ++jj) { u32x4 o; o.x = pk2(v[2 * jj][0], v[2 * jj][1]); o.y = pk2(v[2 * jj][2], v[2 * jj][3]); o.z = pk2(v[2 * jj + 1][0], v[2 * jj + 1][1]); o.w = pk2(v[2 * jj + 1][2], v[2 * jj + 1][3]);
                    *(u32x4*)(HX + (size_t)(row + r) * D + NC0(2 * jj)) = o; }
            }
        }
    }
    if (!GATES && !BF16IN) {
        for (; idx0 + 2 <= nl; idx0 += 2) {
            const int row = r0 + idx0, b = row >> 13;
            if (b != bcur) { bcur = b; const float* mb = modl + (size_t)b * MODW;
#pragma unroll
                for (int j = 0; j < 4; ++j) { const int c0 = NC0(j); gsv[j] = *(const f32x4*)(g + c0) * (*(const f32x4*)(mb + sc_off + c0) + 1.0f); shv[j] = *(const f32x4*)(mb + sh_off + c0); } }
            f32x4 v[2][4];
#pragma unroll
            for (int r = 0; r < 2; ++r)
#pragma unroll
                for (int j = 0; j < 4; ++j) v[r][j] = *(const f32x4*)(xl + (size_t)(row + r) * D + NC0(j));
            asm volatile("" ::: "memory");
#pragma unroll
            for (int r = 0; r < 2; ++r) {
                float ss = 0.f;
#pragma unroll
                for (int j = 0; j < 4; ++j) ss += (v[r][j][0] * v[r][j][0] + v[r][j][1] * v[r][j][1]) + (v[r][j][2] * v[r][j][2] + v[r][j][3] * v[r][j][3]);
                const float rstd = rsqrtf(wave_sum(ss) * (1.0f / D) + EPS);
#pragma unroll
                for (int j = 0; j < 4; ++j) v[r][j] = (v[r][j] * rstd) * gsv[j] + shv[j];
#pragma unroll
                for (int jj = 0; jj < 2; ++jj) { u32x4 o; o.x = pk2(v[r][2 * jj][0], v[r][2 * jj][1]); o.y = pk2(v[r][2 * jj][2], v[r][2 * jj][3]); o.z = pk2(v[r][2 * jj + 1][0], v[r][2 * jj + 1][1]); o.w = pk2(v[r][2 * jj + 1][2], v[r][2 * jj + 1][3]);
                    *(u32x4*)(HX + (size_t)(row + r) * D + NC0(2 * jj)) = o; }
            }
        }
    }
    for (int idx = idx0;; ++idx) {
        const int row = idx < nl ? r0 + idx : TL + gw + (idx - nl) * NGW;
        if (row >= nrows) break;
        const float* xr = row < TL ? xl + (size_t)row * D : xc + (size_t)(row - TL) * D;
        const int b = row < TL ? (row >> 13) : 4;
        if (b != bcur) { bcur = b; const float* mb = modl + (size_t)b * MODW;
#pragma unroll
            for (int j = 0; j < 4; ++j) { const int c0 = NC0(j); gsv[j] = *(const f32x4*)(g + c0) * (*(const f32x4*)(mb + sc_off + c0) + 1.0f); shv[j] = *(const f32x4*)(mb + sh_off + c0); } }
        f32x4 v[4]; float ss = 0.f;
        if (BF16IN && row < TL) { const bf16_t* xbr = (const bf16_t*)xl + (size_t)row * D;
#pragma unroll
            for (int jj = 0; jj < 2; ++jj) { const u32x4 w = *(const u32x4*)(xbr + NC0(2 * jj)); v[2 * jj] = (f32x4){bflo(w.x), bfhi(w.x), bflo(w.y), bfhi(w.y)}; v[2 * jj + 1] = (f32x4){bflo(w.z), bfhi(w.z), bflo(w.w), bfhi(w.w)}; }
        } else {
#pragma unroll
            for (int j = 0; j < 4; ++j) v[j] = *(const f32x4*)(xr + NC0(j)); }
        if (ncp > 0 && row >= TL) {
#pragma unroll
            for (int j = 0; j < 4; ++j) { const int c0 = NC0(j); f32x4 s = *(const f32x4*)(cpart + (size_t)(row - TL) * D + c0);
                for (int p = 1; p < ncp; ++p) s = s + *(const f32x4*)(cpart + ((size_t)p * TC + (row - TL)) * D + c0);
                v[j] = v[j] + *(const f32x4*)(cgate + c0) * s; *(f32x4*)(xco + (size_t)(row - TL) * D + c0) = v[j]; } }
#pragma unroll
        for (int j = 0; j < 4; ++j) ss += (v[j][0] * v[j][0] + v[j][1] * v[j][1]) + (v[j][2] * v[j][2] + v[j][3] * v[j][3]);
        const float rstd = rsqrtf(wave_sum(ss) * (1.0f / D) + EPS);
#pragma unroll
        for (int j = 0; j < 4; ++j) v[j] = (v[j] * rstd) * gsv[j] + shv[j];
#pragma unroll
        for (int jj = 0; jj < 2; ++jj) { u32x4 o; o.x = pk2(v[2 * jj][0], v[2 * jj][1]); o.y = pk2(v[2 * jj][2], v[2 * jj][3]); o.z = pk2(v[2 * jj + 1][0], v[2 * jj + 1][1]); o.w = pk2(v[2 * jj + 1][2], v[2 * jj + 1][3]);
            *(u32x4*)(HX + (size_t)row * D + NC0(2 * jj)) = o; }
        if (GATES) {
            float p[16];
#pragma unroll
            for (int gi = 0; gi < 16; ++gi) { float a = 0.f;
#pragma unroll
                for (int j = 0; j < 4; ++j) { const f32x4 w = *(const LAS f32x4*)(wl + gi * D + NC0(j)); a += (v[j][0] * w[0] + v[j][1] * w[1]) + (v[j][2] * w[2] + v[j][3] * w[3]); }
                p[gi] = a; asm volatile("" ::: "memory"); }
#pragma unroll
            for (int i = 0; i < 8; ++i) { const bool up = lane & 1; const float keep = up ? p[2 * i + 1] : p[2 * i], send = up ? p[2 * i] : p[2 * i + 1]; p[i] = keep + __shfl_xor(send, 1); }
#pragma unroll
            for (int i = 0; i < 4; ++i) { const bool up = lane & 2; const float keep = up ? p[2 * i + 1] : p[2 * i], send = up ? p[2 * i] : p[2 * i + 1]; p[i] = keep + __shfl_xor(send, 2); }
#pragma unroll
            for (int i = 0; i < 2; ++i) { const bool up = lane & 4; const float keep = up ? p[2 * i + 1] : p[2 * i], send = up ? p[2 * i] : p[2 * i + 1]; p[i] = keep + __shfl_xor(send, 4); }
            { const bool up = lane & 8; const float keep = up ? p[1] : p[0], send = up ? p[0] : p[1]; p[0] = keep + __shfl_xor(send, 8); }
            float tot = p[0]; tot += __shfl_xor(tot, 16); tot += __shfl_xor(tot, 32);
            if (lane < 16) { const float pre = tot + bgate[lane]; GT[(size_t)lane * TT + row] = lane < 8 ? pre : logsigmoidf_(pre); }
        }
    }
}
#undef NC0
__device__ __forceinline__ void final_norm(const bf16_t* xb, float* out, const float* g, int wave, int lane) {
    const int gw = blockIdx.x * NWAVES + wave, NGW = gridDim.x * NWAVES;
    const int RPW = (TL + NGW - 1) / NGW, r0 = gw * RPW, r1 = r0 + RPW < TL ? r0 + RPW : TL;
    f32x4 gg[4];
#pragma unroll
    for (int j = 0; j < 4; ++j) gg[j] = *(const f32x4*)(g + 512 * (j >> 1) + 8 * lane + 4 * (j & 1));
    for (int row = r0; row < r1; ++row) {
        const bf16_t* xr = xb + (size_t)row * D; f32x4 v[4]; float ss = 0.f;
#pragma unroll
        for (int jj = 0; jj < 2; ++jj) { const u32x4 w = *(const u32x4*)(xr + 512 * jj + 8 * lane); v[2 * jj] = (f32x4){bflo(w.x), bfhi(w.x), bflo(w.y), bfhi(w.y)}; v[2 * jj + 1] = (f32x4){bflo(w.z), bfhi(w.z), bflo(w.w), bfhi(w.w)}; }
#pragma unroll
        for (int j = 0; j < 4; ++j) ss += (v[j][0] * v[j][0] + v[j][1] * v[j][1]) + (v[j][2] * v[j][2] + v[j][3] * v[j][3]);
        const float rstd = rsqrtf(wave_sum(ss) * (1.0f / D) + EPS);
#pragma unroll
        for (int j = 0; j < 4; ++j) *(f32x4*)(out + (size_t)row * D + 512 * (j >> 1) + 8 * lane + 4 * (j & 1)) = (v[j] * rstd) * gg[j];
    }
}
__device__ __forceinline__ void shortconv_ctx_phase(const bf16_t* Pc, bf16_t* Z, const float* wc  , int tid) {
    const long total = (long)TC * (D / 8);
    for (long it = (long)blockIdx.x * NTHR + tid; it < total; it += (long)gridDim.x * NTHR) {
        const int row = (int)(it >> 7), c0 = (int)(it & 127) * 8, t = row & 255;
        const bool hasl = t != 0, hasr = t != 255;
        const bf16_t* pr = Pc + (size_t)row * 3 * D + 256 * (c0 >> 7) + (c0 & 127);
        float bg[8], u0[8], um[8], up[8], a[8], b[8];
        unpack8(*(const u32x4*)(Pc + (size_t)row * 3 * D + 2048 + c0), bg);
        unpack8(*(const u32x4*)pr, a); unpack8(*(const u32x4*)(pr + 128), b);
#pragma unroll
        for (int j = 0; j < 8; ++j) u0[j] = a[j] * b[j];
        if (hasl) { unpack8(*(const u32x4*)(pr - 3 * D), a); unpack8(*(const u32x4*)(pr - 3 * D + 128), b);
#pragma unroll
            for (int j = 0; j < 8; ++j) um[j] = a[j] * b[j]; } else {
#pragma unroll
            for (int j = 0; j < 8; ++j) um[j] = 0.f; }
        if (hasr) { unpack8(*(const u32x4*)(pr + 3 * D), a); unpack8(*(const u32x4*)(pr + 3 * D + 128), b);
#pragma unroll
            for (int j = 0; j < 8; ++j) up[j] = a[j] * b[j]; } else {
#pragma unroll
            for (int j = 0; j < 8; ++j) up[j] = 0.f; }
        float z[8];
#pragma unroll
        for (int j = 0; j < 8; ++j) z[j] = bg[j] * (wc[c0 + j] * um[j] + wc[D + c0 + j] * u0[j] + wc[2 * D + c0 + j] * up[j]);
        u32x4 o; o.x = pk2(z[0], z[1]); o.y = pk2(z[2], z[3]); o.z = pk2(z[4], z[5]); o.w = pk2(z[6], z[7]);
        *(u32x4*)(Z + (size_t)row * D + c0) = o;
    }
}
__device__ __forceinline__ void act_phase(const bf16_t* GV, bf16_t* Aout, const float* wc  , const float* bc  , int nrows, bool is_ctx, int tid) {
    const long total = (long)nrows * (DFF / 8);
    for (long it = (long)blockIdx.x * NTHR + tid; it < total; it += (long)gridDim.x * NTHR) {
        const int row = (int)(it / (DFF / 8)), c0 = (int)(it % (DFF / 8)) * 8;
        bool hasl, hasr; int S;
        if (!is_ctx) { const int r = (row & 8191) >> 6; hasl = r != 0; hasr = r != 127; S = 64; } else { const int t = row & 255; hasl = t != 0; hasr = t != 255; S = 1; }
        const bf16_t* pr = GV + (size_t)row * 2 * DFF + 256 * (c0 >> 7) + (c0 & 127);
        float g0[8], gm[8], gp[8], vv[8];
        unpack8(*(const u32x4*)pr, g0); unpack8(*(const u32x4*)(pr + 128), vv);
        if (hasl) unpack8(*(const u32x4*)(pr - (size_t)S * 2 * DFF), gm); else {
#pragma unroll
            for (int j = 0; j < 8; ++j) gm[j] = 0.f; }
        if (hasr) unpack8(*(const u32x4*)(pr + (size_t)S * 2 * DFF), gp); else {
#pragma unroll
            for (int j = 0; j < 8; ++j) gp[j] = 0.f; }
        float z[8];
#pragma unroll
        for (int j = 0; j < 8; ++j) { const float gt = wc[c0 + j] * gm[j] + wc[DFF + c0 + j] * g0[j] + wc[2 * DFF + c0 + j] * gp[j] + bc[c0 + j]; z[j] = siluf_(gt) * vv[j]; }
        u32x4 o; o.x = pk2(z[0], z[1]); o.y = pk2(z[2], z[3]); o.z = pk2(z[4], z[5]); o.w = pk2(z[6], z[7]);
        *(u32x4*)(Aout + (size_t)row * DFF + c0) = o;
    }
}

constexpr int SCL = 128, NSC = 2 + SEQ / SCL  , NCH = NB * NH * 2  ;
__device__ __forceinline__ int sc_row0(int b, int sc) { return sc < 2 ? TL + b * CTXL + sc * SCL : b * SEQ + (sc - 2) * SCL; }
constexpr float LOG2E = 1.4426950408889634f;
constexpr int QKW = NH * DK;
constexpr int LD136 = 136;
constexpr int HS_LD = 264;

struct GateScan { int tok0, tok1; float gi0, gi1, bc0, bc1, g; };
__device__ __forceinline__ GateScan gate_scan(const float* GT, int dir, int h, int grow0, int lane) {
    GateScan s; s.tok0 = dir ? 127 - 2 * lane : 2 * lane; s.tok1 = dir ? 126 - 2 * lane : 2 * lane + 1;
    const float* gi = GT + (size_t)(dir * 4 + h) * TT + grow0; const float* gf = GT + (size_t)(8 + dir * 4 + h) * TT + grow0;
    s.gi0 = gi[s.tok0]; s.gi1 = gi[s.tok1]; const float f0 = gf[s.tok0], f1 = gf[s.tok1];
    const float incl = prefix_sum64(f0 + f1, lane);
    s.bc0 = incl - f1; s.bc1 = incl; s.g = __shfl(incl, 63);
    return s;
}

__device__ __forceinline__ void mlstm_p1(LAS unsigned char* lds, const bf16_t* Kb, const bf16_t* VT, const float* GT, bf16_t* UC, float* GM, float* NST, int tid, int wave, int lane) {
    LAS float* s_wa = (LAS float*)lds;
    LAS bf16_t* img[2] = {(LAS bf16_t*)(lds + 2048), (LAS bf16_t*)(lds + 2048 + 128 * LD136 * 2)};
    const int l31 = lane & 31, hh = lane >> 5;
    for (int u = blockIdx.x; u < NB * NH * NSC; u += gridDim.x) {
        const int sc = u % NSC, bh = u / NSC, h = bh & 3, b = bh >> 2;
        const int row0 = sc_row0(b, sc);
        const int v = 32 * wave + l31;
        bf16x8 vt[8];
#pragma unroll
        for (int ks = 0; ks < 8; ++ks) vt[ks] = *(const bf16x8*)(VT + ((size_t)(((((row0 >> 7) * 4 + h) * 8 + wave) * 8 + ks) * 2 + hh) * 32 + l31) * 8);
        if (wave < 2) {
            const int dir = wave; const GateScan s = gate_scan(GT, dir, h, row0, lane);
            const float a0 = s.g - s.bc0 + s.gi0, a1 = s.g - s.bc1 + s.gi1, mloc = wave_max(fmaxf(a0, a1));
            s_wa[dir * 128 + s.tok0] = __expf(a0 - mloc); s_wa[dir * 128 + s.tok1] = __expf(a1 - mloc);
            if (lane == 0) { float* gm = GM + ((size_t)((b * 4 + h) * 2 + dir) * NSC + sc) * 4; gm[0] = s.g; gm[1] = mloc; }
        }
        __syncthreads();
#pragma unroll
        for (int k = 0; k < 2; ++k) {
            const int s2 = tid & 63, d8 = ((tid >> 6) + 8 * k) * 8;
            float k0[8], k1[8];
            unpack8(*(const u32x4*)(Kb + (size_t)(row0 + 2 * s2) * QKW + h * DK + d8), k0); unpack8(*(const u32x4*)(Kb + (size_t)(row0 + 2 * s2 + 1) * QKW + h * DK + d8), k1);
#pragma unroll
            for (int dir = 0; dir < 2; ++dir) { const float w0 = s_wa[dir * 128 + 2 * s2], w1 = s_wa[dir * 128 + 2 * s2 + 1];
#pragma unroll
                for (int j = 0; j < 8; ++j) *(LAS unsigned*)(img[dir] + (d8 + j) * LD136 + 2 * s2) = pk2(k0[j] * w0, k1[j] * w1); }
        }
        __syncthreads();
        if (tid < 256) {
            const int dir = tid >> 7, d = tid & 127; float sum = 0.f;
#pragma unroll
            for (int k8 = 0; k8 < 16; ++k8) { float f[8]; unpack8(*(const LAS u32x4*)(img[dir] + d * LD136 + 8 * k8), f);
#pragma unroll
                for (int j = 0; j < 8; ++j) sum += f[j]; }
            NST[((size_t)((b * 4 + h) * 2 + dir) * NSC + sc) * DK + d] = sum;
        }
#pragma unroll
        for (int dir = 0; dir < 2; ++dir) {
            bf16_t* up = UC + ((size_t)((b * 4 + h) * 2 + dir) * NSC + sc) * DV * DK + (wave * 16 * 32 + l31) * 8 + 4 * hh;
#pragma unroll
            for (int dt = 0; dt < 4; ++dt) {
                f32x16 acc;
#pragma unroll
                for (int r = 0; r < 16; ++r) acc[r] = 0.f;
#pragma unroll
                for (int ks = 0; ks < 8; ++ks) { const bf16x8 a = *(const LAS bf16x8*)(img[dir] + (32 * dt + l31) * LD136 + 16 * ks + 8 * hh);
                    acc = __builtin_amdgcn_mfma_f32_32x32x16_bf16(a, vt[ks], acc, 0, 0, 0); }
#pragma unroll
                for (int i4 = 0; i4 < 4; ++i4) { v2u o; o.x = pk2(acc[4 * i4], acc[4 * i4 + 1]); o.y = pk2(acc[4 * i4 + 2], acc[4 * i4 + 3]);
                    *(v2u*)(up + ((4 * (dt & 1) + i4) * 2 + (dt >> 1)) * 256) = o; }
            }
        }
        __syncthreads();
    }
}
__device__ __forceinline__ void mlstm_p2(bf16_t* UC, float* GM, float* NST, int tid) {
    for (int item = blockIdx.x * NTHR + tid; item < NCH * 8192; item += gridDim.x * NTHR) {
        const int ch = item >> 13, e = item & 8191, dir = ch & 1;
        float c0 = 0.f, c1 = 0.f, c2 = 0.f, c3 = 0.f, nn = 0.f, m = 0.f;
        for (int st = 0; st < NSC; st += 6) {
            v2u uu[6]; float gg[6], ml[6], un[6]; int scs[6];
#pragma unroll
            for (int k = 0; k < 6; ++k) { const int s = st + k; const int sc = dir == 0 ? s : (s < 2 ? 1 - s : NSC + 1 - s); scs[k] = sc;
                const size_t ci = (size_t)ch * NSC + sc;
                uu[k] = *(const v2u*)(UC + ci * (DV * DK) + (size_t)e * 4); gg[k] = GM[ci * 4]; ml[k] = GM[ci * 4 + 1];
                un[k] = e < DK ? NST[ci * DK + e] : 0.f; }
#pragma unroll
            for (int k = 0; k < 6; ++k) { const size_t ci = (size_t)ch * NSC + scs[k];
                const float mn = fmaxf(gg[k] + m, ml[k]), dec = __expf(gg[k] + m - mn), sc = __expf(ml[k] - mn);
                v2u o; o.x = pk2(c0, c1); o.y = pk2(c2, c3);
                *(v2u*)(UC + ci * (DV * DK) + (size_t)e * 4) = o;
                if (e < DK) NST[ci * DK + e] = nn;
                if (e == 0) GM[ci * 4 + 2] = m;
                c0 = dec * c0 + sc * bflo(uu[k].x); c1 = dec * c1 + sc * bfhi(uu[k].x); c2 = dec * c2 + sc * bflo(uu[k].y); c3 = dec * c3 + sc * bfhi(uu[k].y);
                nn = dec * nn + sc * un[k]; m = mn; }
        }
    }
}
__device__ __forceinline__ void mlstm_p3(LAS unsigned char* lds, const bf16_t* Qb, const bf16_t* Ob, const bf16_t* Kb, const bf16_t* VT, const bf16_t* UC, const float* GM, const float* NST,
                                         const float* GT, const float* gain, bf16_t* HN, bool emit_ctx, int tid, int wave, int lane) {
    LAS float* s_bc = (LAS float*)lds;
    LAS float* s_ii = s_bc + 256;
    LAS float* s_mt = s_ii + 256;
    LAS float* s_wi = s_mt + 256;
    LAS float* s_r = s_wi + 256;
    LAS float* s_n0 = s_r + 128;
    LAS bf16_t* Qi = (LAS bf16_t*)(lds + 8192);
    LAS bf16_t* Ki = Qi + 64 * LD136;
    LAS bf16_t* Wi[2] = {Ki + 128 * LD136, Ki + 128 * LD136 + 64 * LD136};
    LAS bf16_t* Qp[2] = {Wi[1] + 64 * LD136, Wi[1] + 128 * LD136};
    LAS float* Hs = (LAS float*)(lds + 8192 + (64 + 128) * LD136 * 2);
    LAS float* s_dp = (LAS float*)(lds + 130048);
    const int l31 = lane & 31, hh = lane >> 5, l15 = lane & 15, q4 = lane >> 4;
    const int nsq = emit_ctx ? NSC : NSC - 2, nun = NB * NH * nsq;
    if ((int)blockIdx.x < nun) {
        const int u = blockIdx.x, sc = (u % nsq) + (emit_ctx ? 0 : 2), bh = u / nsq, h = bh & 3, b = bh >> 2, srow0 = sc_row0(b, sc);
#pragma unroll
        for (int k = 0; k < 4; ++k) { const int q = tid + NTHR * k, r = q >> 4, c8 = (q & 15) * 8;
            *(LAS u32x4*)(Ki + r * LD136 + c8) = *(const u32x4*)(Kb + (size_t)(srow0 + r) * QKW + h * DK + c8); }
#pragma unroll
        for (int k = 0; k < 2; ++k) { const int q = tid + NTHR * k, r = q >> 4, c8 = (q & 15) * 8;
            *(LAS u32x4*)(Qi + r * LD136 + c8) = *(const u32x4*)(Qb + (size_t)(srow0 + r) * QKW + h * DK + c8); }
    }
    for (int u = blockIdx.x; u < nun; u += gridDim.x) {
        const int sc = (u % nsq) + (emit_ctx ? 0 : 2), bh = u / nsq, h = bh & 3, b = bh >> 2;
        const int srow0 = sc_row0(b, sc);
        const int chF = (b * 4 + h) * 2;
        const int v = 32 * wave + l31;
        const int un = u + gridDim.x; const bool has_next = un < nun;
        const int scn = (un % nsq) + (emit_ctx ? 0 : 2), bhn = un / nsq, hn = bhn & 3;
        const int srow0n = has_next ? sc_row0(bhn >> 2, scn) : srow0;
        int tl = tid; asm volatile("" : "+v"(tl));
        if (wave < 2) {
            const int dir = wave; const GateScan s = gate_scan(GT, dir, h, srow0, lane);
            const float m0 = GM[((size_t)(chF + dir) * NSC + sc) * 4 + 2];
            const float e0 = s.gi0 - s.bc0, e1 = s.gi1 - s.bc1;
            const float pmx = prefix_max64(fmaxf(e0, e1), lane); float exm = __shfl_up(pmx, 1); if (lane == 0) exm = -3.0e38f;
            const float pm0 = fmaxf(exm, e0), pm1 = pmx;
            s_bc[dir * 128 + s.tok0] = (s.gi0 - s.bc0) * LOG2E; s_bc[dir * 128 + s.tok1] = (s.gi1 - s.bc1) * LOG2E;
            { const float mt = s.bc0 + fmaxf(m0, pm0); s_mt[dir * 128 + s.tok0] = mt; s_ii[dir * 128 + s.tok0] = (s.bc0 - mt) * LOG2E; s_wi[dir * 128 + s.tok0] = __expf(s.bc0 + m0 - mt); }
            { const float mt = s.bc1 + fmaxf(m0, pm1); s_mt[dir * 128 + s.tok1] = mt; s_ii[dir * 128 + s.tok1] = (s.bc1 - mt) * LOG2E; s_wi[dir * 128 + s.tok1] = __expf(s.bc1 + m0 - mt); }
        } else if (wave < 6) { const int i = tid - 128, dir = i >> 7, d = i & 127; s_n0[i] = NST[((size_t)(chF + dir) * NSC + sc) * DK + d]; }
#pragma unroll 1
        for (int half = 0; half < 2; ++half) {
            const int qrow0 = srow0 + 64 * half;
            int th = tl; asm volatile("" : "+v"(th));
            const int tid = th, lane = th & 63, l31 = lane & 31, hh = lane >> 5, l15 = lane & 15, q4 = lane >> 4, v = 32 * wave + l31;
            __syncthreads();
#pragma unroll
            for (int k4 = 0; k4 < 4; ++k4) {
                const int idx = 4 * wave + k4, si = idx >> 2, ti = idx & 3;
                f32x4 acc = {0.f, 0.f, 0.f, 0.f};
#pragma unroll
                for (int ks = 0; ks < 4; ++ks) { const bf16x8 a = *(const LAS bf16x8*)(Ki + (16 * si + l15) * LD136 + 32 * ks + 8 * q4), bq = *(const LAS bf16x8*)(Qi + (16 * ti + l15) * LD136 + 32 * ks + 8 * q4);
                    acc = __builtin_amdgcn_mfma_f32_16x16x32_bf16(a, bq, acc, 0, 0, 0); }
                const int t = 16 * ti + l15, tg = 64 * half + t, s0 = 16 * si + 4 * q4;
                const int rel = si - (4 * half + ti);
#pragma unroll
                for (int dir = 0; dir < 2; ++dir) {
                    const bool zero = dir == 0 ? rel > 0 : rel < 0, full = dir == 0 ? rel < 0 : rel > 0;
                    if (zero) { v2u o; o.x = 0u; o.y = 0u; *(LAS v2u*)(Wi[dir] + t * LD136 + s0) = o; if (q4 == 0) s_dp[(dir * 64 + t) * 9 + si] = 0.f; }
                    else {
                        const float qq = s_ii[dir * 128 + tg]; const f32x4 kq = *(const LAS f32x4*)(s_bc + dir * 128 + s0); float ev[4];
#pragma unroll
                        for (int j = 0; j < 4; ++j) ev[j] = __builtin_amdgcn_exp2f(qq + kq[j]);
                        if (!full) {
#pragma unroll
                            for (int j = 0; j < 4; ++j) { const int s = s0 + j; const bool ok = dir == 0 ? (s <= tg) : (s >= tg); ev[j] = ok ? ev[j] : 0.f; } }
                        v2u o; o.x = pk2(ev[0] * acc[0], ev[1] * acc[1]); o.y = pk2(ev[2] * acc[2], ev[3] * acc[3]);
                        *(LAS v2u*)(Wi[dir] + t * LD136 + s0) = o;
                        float sum = (bflo(o.x) + bfhi(o.x)) + (bflo(o.y) + bfhi(o.y));
                        sum += __shfl_xor(sum, 16); sum += __shfl_xor(sum, 32);
                        if (q4 == 0) s_dp[(dir * 64 + t) * 9 + si] = sum;
                    }
                }
            }
            { const int dir = tid >> 8, t = (tid >> 2) & 63, part = tid & 3; const float wi = s_wi[dir * 128 + 64 * half + t]; float qn = 0.f;
#pragma unroll
              for (int k = 0; k < 4; ++k) { float qf[8]; unpack8(*(const LAS u32x4*)(Qi + t * LD136 + 32 * part + 8 * k), qf);
                  u32x4 o; o.x = pk2(wi * qf[0], wi * qf[1]); o.y = pk2(wi * qf[2], wi * qf[3]); o.z = pk2(wi * qf[4], wi * qf[5]); o.w = pk2(wi * qf[6], wi * qf[7]);
                  *(LAS u32x4*)(Qp[dir] + t * LD136 + 32 * part + 8 * k) = o;
                  const f32x4 na = *(const LAS f32x4*)(s_n0 + dir * 128 + 32 * part + 8 * k), nb = *(const LAS f32x4*)(s_n0 + dir * 128 + 32 * part + 8 * k + 4);
                  qn += (bflo(o.x) * na[0] + bfhi(o.x) * na[1]) + (bflo(o.y) * na[2] + bfhi(o.y) * na[3]) + (bflo(o.z) * nb[0] + bfhi(o.z) * nb[1]) + (bflo(o.w) * nb[2] + bfhi(o.w) * nb[3]); }
              qn += __shfl_xor(qn, 1); qn += __shfl_xor(qn, 2);
              if (part == 0) s_dp[(dir * 64 + t) * 9 + 8] = qn; }
            bf16x8 cf[2][8];
#pragma unroll
            for (int dir = 0; dir < 2; ++dir)
#pragma unroll
                for (int ks = 0; ks < 8; ++ks) cf[dir][ks] = *(const bf16x8*)(UC + ((size_t)(chF + dir) * NSC + sc) * DV * DK + (((wave * 8 + ks) * 2 + hh) * 32 + l31) * 8);
            __syncthreads();
            if (tid < 128) { float den = 0.f;
#pragma unroll
                for (int q = 0; q < 9; ++q) den += s_dp[tid * 9 + q];
                s_r[tid] = 1.0f / fmaxf(fabsf(den), __expf(-s_mt[(tid >> 6) * 128 + 64 * half + (tid & 63)])); }
            const bool pfq = half == 0 || has_next, pfk = half == 1 && has_next;
            u32x4 pq[2], pk[4];
            { const int nrow0 = half == 0 ? srow0 + 64 : srow0n, nh = half == 0 ? h : hn;
              if (pfq) {
#pragma unroll
                  for (int k = 0; k < 2; ++k) { const int q = tl + NTHR * k, r = q >> 4, c8 = (q & 15) * 8; pq[k] = *(const u32x4*)(Qb + (size_t)(nrow0 + r) * QKW + nh * DK + c8); } }
              if (pfk) {
#pragma unroll
                  for (int k = 0; k < 4; ++k) { const int q = tl + NTHR * k, r = q >> 4, c8 = (q & 15) * 8; pk[k] = *(const u32x4*)(Kb + (size_t)(srow0n + r) * QKW + hn * DK + c8); } } }
            asm volatile("" ::: "memory");
            f32x16 acc[2][2];
#pragma unroll
            for (int tt = 0; tt < 2; ++tt) {
#pragma unroll
                for (int r = 0; r < 16; ++r) acc[0][tt][r] = 0.f;
#pragma unroll
                for (int ks = 0; ks < 8; ++ks) { const bf16x8 a = *(const LAS bf16x8*)(Qp[0] + (32 * tt + l31) * LD136 + 64 * hh + 8 * ks);
                    acc[0][tt] = __builtin_amdgcn_mfma_f32_32x32x16_bf16(a, cf[0][ks], acc[0][tt], 0, 0, 0); }
            }
            bf16x8 vt[8];
#pragma unroll
            for (int ks = 0; ks < 8; ++ks) vt[ks] = *(const bf16x8*)(VT + ((size_t)(((((srow0 >> 7) * 4 + h) * 8 + wave) * 8 + ks) * 2 + hh) * 32 + l31) * 8);
            asm volatile("" ::: "memory");
#pragma unroll
            for (int tt = 0; tt < 2; ++tt) {
#pragma unroll
                for (int r = 0; r < 16; ++r) acc[1][tt][r] = 0.f;
#pragma unroll
                for (int ks = 0; ks < 8; ++ks) { const bf16x8 a = *(const LAS bf16x8*)(Qp[1] + (32 * tt + l31) * LD136 + 64 * hh + 8 * ks);
                    acc[1][tt] = __builtin_amdgcn_mfma_f32_32x32x16_bf16(a, cf[1][ks], acc[1][tt], 0, 0, 0); }
            }
            if (pfq) {
#pragma unroll
                for (int k = 0; k < 2; ++k) { const int q = tl + NTHR * k, r = q >> 4, c8 = (q & 15) * 8; *(LAS u32x4*)(Qi + r * LD136 + c8) = pq[k]; } }
            if (pfk) {
#pragma unroll
                for (int k = 0; k < 4; ++k) { const int q = tl + NTHR * k, r = q >> 4, c8 = (q & 15) * 8; *(LAS u32x4*)(Ki + r * LD136 + c8) = pk[k]; } }
            asm volatile("" ::: "memory");
#pragma unroll
            for (int dir = 0; dir < 2; ++dir)
#pragma unroll
                for (int tt = 0; tt < 2; ++tt)
#pragma unroll
                    for (int ks = 0; ks < 8; ++ks) { const bf16x8 a = *(const LAS bf16x8*)(Wi[dir] + (32 * tt + l31) * LD136 + 16 * ks + 8 * hh);
                        acc[dir][tt] = __builtin_amdgcn_mfma_f32_32x32x16_bf16(a, vt[ks], acc[dir][tt], 0, 0, 0); }
            __syncthreads();
#pragma unroll
            for (int tt = 0; tt < 2; ++tt)
#pragma unroll
                for (int r4 = 0; r4 < 4; ++r4) { const int t0 = 32 * tt + 8 * r4 + 4 * hh; const f32x4 rf = *(const LAS f32x4*)(s_r + t0), rb = *(const LAS f32x4*)(s_r + 64 + t0);
#pragma unroll
                    for (int j = 0; j < 4; ++j) Hs[(t0 + j) * HS_LD + v] = rf[j] * acc[0][tt][4 * r4 + j] + rb[j] * acc[1][tt][4 * r4 + j]; }
            u32x4 ov[4];
#pragma unroll
            for (int k4 = 0; k4 < 4; ++k4) ov[k4] = *(const u32x4*)(Ob + (size_t)(qrow0 + (tl >> 3)) * D + h * DV + 32 * (tl & 7) + 8 * k4);
            __syncthreads();
            { const int t = tid >> 3, seg = tid & 7;
              f32x4 hq[8]; float ss = 0.f;
#pragma unroll
              for (int k = 0; k < 8; ++k) { hq[k] = *(const LAS f32x4*)(Hs + t * HS_LD + 32 * seg + 4 * k); ss += (hq[k][0] * hq[k][0] + hq[k][1] * hq[k][1]) + (hq[k][2] * hq[k][2] + hq[k][3] * hq[k][3]); }
              ss += __shfl_xor(ss, 1); ss += __shfl_xor(ss, 2); ss += __shfl_xor(ss, 4);
              const float rstd = rsqrtf(ss * (1.0f / DV) + EPS);
              bf16_t* op = HN + (size_t)(qrow0 + t) * D + h * DV + 32 * seg;
#pragma unroll
              for (int k4 = 0; k4 < 4; ++k4) { float of[8]; unpack8(ov[k4], of); float y[8];
                  const f32x4 ga = *(const f32x4*)(gain + h * DV + 32 * seg + 8 * k4), gb = *(const f32x4*)(gain + h * DV + 32 * seg + 8 * k4 + 4);
#pragma unroll
                  for (int j = 0; j < 8; ++j) { const int c = 8 * k4 + j; y[j] = hq[c >> 2][c & 3] * (rstd * (j < 4 ? ga[j & 3] : gb[j & 3])) * sigmoidf_(of[j]); }
                  u32x4 w; w.x = pk2(y[0], y[1]); w.y = pk2(y[2], y[3]); w.z = pk2(y[4], y[5]); w.w = pk2(y[6], y[7]);
                  *(u32x4*)(op + 8 * k4) = w; } }
            __syncthreads();
        }
    }
}
}

#ifndef MK_MULTI
#define MK_MULTI 0
#endif
struct Args { Ptrs p; int ph_lo, ph_hi; };
constexpr int PH_MLSTM = 6, PH_SCONV = 4;
constexpr int NPHASES = 2 + 2 * (PH_MLSTM + PH_SCONV) + (4 + 4 + 3 + 3) + 1;

__global__ void __launch_bounds__(NTHR, 2) fwd_kernel(Args args) {
    extern __shared__ __attribute__((aligned(16))) unsigned char lds_raw[];
    LAS unsigned char* lds = (LAS unsigned char*)lds_raw;
    const Ptrs& P = args.p;
    volatile LAS unsigned* MISC = (volatile LAS unsigned*)(lds + MISC_OFF);
    if (threadIdx.x < 32) MISC[threadIdx.x] = 0u;
    __syncthreads();
    unsigned* ctl = (unsigned*)(P.ws + WS_CTL);
    XcdBarrier bar; bar.bar = ctl + CW_BAR; bar.x = 0; bar.st = nullptr;
    if (!MK_MULTI) bar = xcd_barrier_post(ctl + CW_BAR, MISC + 8);
    const int lo = args.ph_lo, hi = args.ph_hi;
    int ph = 0;
#define PH_BEGIN if (ph >= lo && ph < hi) { int tid_l = threadIdx.x; asm volatile("" : "+v"(tid_l)); const int tid = tid_l, lane = tid & 63, wave = __builtin_amdgcn_readfirstlane(tid >> 6); (void)lane; (void)wave;
#define PH_END   if (ph + 1 < hi) xcd_barrier(bar); else { asm volatile("s_waitcnt vmcnt(0)" ::: "memory"); __syncthreads(); } } ++ph;

    unsigned char* ws = P.ws;
    float* MOD = (float*)(ws + WS_MOD);
    float* GT = (float*)(ws + WS_GATES);
    float* GM = (float*)(ws + WS_GM);
    float* NST = (float*)(ws + WS_NST);
    float* CTXRES = (float*)(ws + WS_CTXRES);
    bf16_t* WB = (bf16_t*)(ws + WS_W);
    bf16_t* HX = (bf16_t*)(ws + WS_HX);
    unsigned char* BIG = ws + WS_BIG;
    bf16_t* XB = (bf16_t*)P.out;
    bf16_t* XF = (bf16_t*)(BIG + BIG_XF);
    float* CPART = (float*)(BIG + BIG_CPART);

    PH_BEGIN
        p0_convert(P, lds, wave, lane);
        __syncthreads();
        p0_mod(P, lds, tid);
        {
            bf16_t* WG = WB + W_AING / 2;
            for (int e = blockIdx.x * NTHR + tid; e < 2 * 256 * D; e += gridDim.x * NTHR) {
                const int j = e >> 18, n = (e >> 10) & 255, k = e & 1023; float w = 0.f;
                if (n < 32) { const float f = P.a_w_in[((size_t)j * D + k) * APROJ + 3072 + (n & 15)]; const float hi = bfround(f); w = n < 16 ? hi : f - hi; }
                WG[e] = (bf16_t)f2bf(w);
            }
        }
    PH_END
    PH_BEGIN
        mod_reduce(P, tid);
    PH_END

#pragma unroll 1
    for (int lp = 0; lp < 2; ++lp) {
        {
            const int i = 2 * lp, j = lp;
            const float* xc = i == 0 ? P.ctx : CTXRES;
            const float* modl = MOD + (size_t)i * 5 * MODW;
            const bool emit_ctx = i == 0;
            bf16_t* Qb = (bf16_t*)(BIG + BIG_Q); bf16_t* Ob = (bf16_t*)(BIG + BIG_O); bf16_t* Kb = (bf16_t*)(BIG + BIG_K); bf16_t* VT = (bf16_t*)(BIG + BIG_VT); bf16_t* UC = (bf16_t*)(BIG + BIG_UC);
            const bf16_t* Wain = WB + W_AIN / 2 + (size_t)j * 3072 * D;
            PH_BEGIN
if (i == 0) norm_phase<false, false>(P.x, xc, CTXRES, CPART, 0, MOD, TT, P.g_mix + (size_t)i * D, modl, 0, D, HX, nullptr, nullptr, nullptr, lds, tid, wave, lane); else norm_phase<false, true>((const float*)XB, xc, CTXRES, CPART, 4, MOD + (size_t)(i - 1) * 5 * MODW + 4 * MODW + 5 * D, TT, P.g_mix + (size_t)i * D, modl, 0, D, HX, nullptr, nullptr, nullptr, lds, tid, wave, lane);
            PH_END
            PH_BEGIN
                {
                    EpiQOK E{Qb, Ob, Kb, 0};
                    run_gemm(lds, HX, Wain, TL, 2048, D, E);
                    EpiQOK Ec{Qb, Ob, Kb, TL};
                    run_gemm(lds, HX + (size_t)TL * D, Wain, TC, 2048, D, Ec);
                }
                {
                    EpiVT E{VT, 0};
                    run_gemm(lds, Wain + (size_t)2048 * D, HX, 1024, TL, D, E);
                    EpiVT Ec{VT, TL};
                    run_gemm(lds, Wain + (size_t)2048 * D, HX + (size_t)TL * D, 1024, TC, D, Ec, 240);
                }
                {
                    const bf16_t* Wg = WB + W_AING / 2 + (size_t)j * 256 * D;
                    EpiGates Eg{GT, P.a_b_gate + j * 16, 0};
                    run_gemm(lds, HX, Wg, TL, 256, D, Eg, 32);
                    EpiGates Egc{GT, P.a_b_gate + j * 16, TL};
                    run_gemm(lds, HX + (size_t)TL * D, Wg, TC, 256, D, Egc, 160);
                }
            PH_END
            PH_BEGIN
mlstm_p1(lds, Kb, VT, GT, UC, GM, NST, tid, wave, lane);
            PH_END
            PH_BEGIN
                mlstm_p2(UC, GM, NST, tid);
            PH_END
            PH_BEGIN
mlstm_p3(lds, Qb, Ob, Kb, VT, UC, GM, NST, GT, P.a_head_gain + (size_t)j * D, HX, emit_ctx, tid, wave, lane);
            PH_END
            PH_BEGIN
                {
                    if (i == 0) { EpiResidual<true, true> E{P.x, XB, modl + 2 * D, 32}; run_gemm(lds, HX, WB + W_AOUT / 2 + (size_t)j * D * D, TL, D, D, E); }
                    else { EpiResidual<false, true> E{XB, XB, modl + 2 * D, 32}; run_gemm(lds, HX, WB + W_AOUT / 2 + (size_t)j * D * D, TL, D, D, E); }
                    if (emit_ctx) {
                        EpiPartF32 E0{CPART}, E1{CPART + (size_t)TC * D};
                        run_gemm_slice(lds, HX + (size_t)TL * D, WB + W_AOUT / 2 + (size_t)j * D * D, TC, D, 0, 512, D, 0, E0);
                        run_gemm_slice(lds, HX + (size_t)TL * D, WB + W_AOUT / 2 + (size_t)j * D * D, TC, D, 512, 512, D, 128, E1); }
                }
            PH_END
        }
#pragma unroll 1
        for (int sub = 0; sub < 2; ++sub) {
            const int i = 2 * lp + sub;
            const float* modl = MOD + (size_t)i * 5 * MODW;
            const bool ctx_live = i < 2;
            if (sub == 1) {
                const int j = lp;
                bf16_t* CU = (bf16_t*)(BIG + BIG_CU); bf16_t* Z = (bf16_t*)(BIG + BIG_Z); bf16_t* Pc = (bf16_t*)(BIG + BIG_PC);
                const bf16_t* Wbin = WB + W_BIN / 2 + (size_t)j * 3 * D * D;
                const int nrows = ctx_live ? TT : TL;
                PH_BEGIN
norm_phase<false, true>((const float*)XB, CTXRES, CTXRES, CPART, ctx_live ? 4 : 0, MOD + (size_t)(i - 1) * 5 * MODW + 4 * MODW + 5 * D, nrows, P.g_mix + (size_t)i * D, modl, 0, D, HX, nullptr, nullptr, nullptr, lds, tid, wave, lane);
                PH_END
                PH_BEGIN
{ EpiConvU E{CU, P.b_w_conv + (size_t)j * 3 * D}; run_gemm<EpiConvU, SeqStripA>(lds, HX, Wbin, TL, 2 * D, D, E); }
                    if (ctx_live) { EpiStoreBf16 Ec{Pc, 3 * D, 0, 0}; run_gemm(lds, HX + (size_t)TL * D, Wbin, TC, 3 * D, D, Ec); }
                PH_END
                PH_BEGIN
{ EpiMulZ E{CU, Z}; run_gemm(lds, HX, Wbin + (size_t)2 * D * D, TL, D, D, E); }
                    if (ctx_live) shortconv_ctx_phase(Pc, Z + (size_t)TL * D, P.b_w_conv + (size_t)j * 3 * D, tid);
                PH_END
                PH_BEGIN
                    {
                        EpiResidual<false, true> E{XB, XB, modl + 2 * D, 32};
                        run_gemm(lds, Z, WB + W_BOUT / 2 + (size_t)j * D * D, TL, D, D, E);
                        if (ctx_live) { EpiPartF32 E0{CPART}, E1{CPART + (size_t)TC * D};
                            run_gemm_slice(lds, Z + (size_t)TL * D, WB + W_BOUT / 2 + (size_t)j * D * D, TC, D, 0, 512, D, 0, E0);
                            run_gemm_slice(lds, Z + (size_t)TL * D, WB + W_BOUT / 2 + (size_t)j * D * D, TC, D, 512, 512, D, 128, E1); }
                    }
                PH_END
            }
            {
                bf16_t* Abuf = (bf16_t*)(BIG + BIG_A); bf16_t* GVC = (bf16_t*)(BIG + BIG_GVC);
                const bf16_t* Wup = WB + W_UP / 2 + (size_t)i * 2 * DFF * D; const bf16_t* Wdn = WB + W_DN / 2 + (size_t)i * D * DFF;
                const int nrows = ctx_live ? TT : TL;
                PH_BEGIN
norm_phase<false, true>((const float*)XB, i == 0 ? P.ctx : CTXRES, CTXRES, CPART, ctx_live ? 2 : 0, modl + 4 * MODW + 2 * D, nrows, P.g_ffn + (size_t)i * D, modl, 3 * D, 4 * D, HX, nullptr, nullptr, nullptr, lds, tid, wave, lane);
                PH_END
                PH_BEGIN
{ EpiConvGLU E{Abuf, P.f_w_conv + (size_t)i * 3 * DFF, P.f_b_conv + (size_t)i * DFF}; run_gemm<EpiConvGLU, ColStripA>(lds, HX, Wup, TL, 2 * DFF, D, E); }
                    if (ctx_live) { EpiStoreBf16 Ec{GVC, 2 * DFF, 0, 0}; run_gemm(lds, HX + (size_t)TL * D, Wup, TC, 2 * DFF, D, Ec); }
                PH_END
                if (ctx_live) {
                    PH_BEGIN
                        act_phase(GVC, Abuf + (size_t)TL * DFF, P.f_w_conv + (size_t)i * 3 * DFF, P.f_b_conv + (size_t)i * DFF, TC, true, tid);
                    PH_END
                }
                PH_BEGIN
                    {
                        { EpiResidual<false, true> E{XB, i == 3 ? XF : XB, modl + 5 * D, 32}; run_gemm(lds, Abuf, Wdn, TL, D, DFF, E); }
                        if (ctx_live) {
                            EpiPartF32 E0{CPART}, E1{CPART + (size_t)TC * D}, E2{CPART + (size_t)2 * TC * D}, E3{CPART + (size_t)3 * TC * D};
                            run_gemm_slice(lds, Abuf + (size_t)TL * DFF, Wdn, TC, D, 0, 768, DFF, 0, E0);
                            run_gemm_slice(lds, Abuf + (size_t)TL * DFF, Wdn, TC, D, 768, 768, DFF, 64, E1);
                            run_gemm_slice(lds, Abuf + (size_t)TL * DFF, Wdn, TC, D, 1536, 640, DFF, 128, E2);
                            run_gemm_slice(lds, Abuf + (size_t)TL * DFF, Wdn, TC, D, 2176, 640, DFF, 192, E3); }
                    }
                PH_END
            }
        }
    }
    PH_BEGIN
        final_norm(XF, P.out, P.g_final, wave, lane);
    PH_END
#undef PH_BEGIN
#undef PH_END
}

extern "C" void kernel_launch(void* const* d_in, const int* in_sizes, int n_in, void* d_out, int out_size, void* d_ws, size_t ws_size, hipStream_t stream) {
    static int grid = 0;
    if (grid == 0) {
        if (n_in != 20 || out_size != TL * D || ws_size < WS_END) { fprintf(stderr, "kernel_launch: unexpected problem (n_in %d, out %d, ws %zu < %zu)\n", n_in, out_size, ws_size, (size_t)WS_END); grid = -1; return; }
        int dev = 0, cus = 0, per_cu = 0;
        if (hipGetDevice(&dev) != hipSuccess || hipDeviceGetAttribute(&cus, hipDeviceAttributeMultiprocessorCount, dev) != hipSuccess) { grid = -1; return; }
        if (hipFuncSetAttribute((const void*)fwd_kernel, hipFuncAttributeMaxDynamicSharedMemorySize, LDS_BYTES) != hipSuccess) { grid = -1; return; }
        if (hipOccupancyMaxActiveBlocksPerMultiprocessor(&per_cu, (const void*)fwd_kernel, NTHR, LDS_BYTES) != hipSuccess || per_cu < 1) { fprintf(stderr, "kernel_launch: occupancy query says %d\n", per_cu); }
        (void)hipGetLastError();
        grid = cus;
    }
    if (grid < 0) return;
    (void)hipMemsetAsync((char*)d_ws + WS_CTL, 0, CTL_ZERO_BYTES, stream);
    Args a{};
    const float* const* in = (const float* const*)d_in;
    a.p.x = in[0]; a.p.c = in[1]; a.p.ctx = in[2]; a.p.c_ctx = in[3]; a.p.w_mod = in[4]; a.p.b_mod = in[5]; a.p.g_mix = in[6]; a.p.g_ffn = in[7];
    a.p.a_w_in = in[8]; a.p.a_b_gate = in[9]; a.p.a_head_gain = in[10]; a.p.a_w_out = in[11]; a.p.b_w_in = in[12]; a.p.b_w_conv = in[13]; a.p.b_w_out = in[14];
    a.p.f_w_up = in[15]; a.p.f_w_conv = in[16]; a.p.f_b_conv = in[17]; a.p.f_w_down = in[18]; a.p.g_final = in[19];
    a.p.out = (float*)d_out; a.p.ws = (unsigned char*)d_ws;
#if MK_MULTI
    for (int p = 0; p < NPHASES; ++p) { a.ph_lo = p; a.ph_hi = p + 1; hipLaunchKernelGGL(fwd_kernel, dim3(grid), dim3(NTHR), LDS_BYTES, stream, a); }
#else
    a.ph_lo = 0; a.ph_hi = NPHASES;
    hipLaunchKernelGGL(fwd_kernel, dim3(grid), dim3(NTHR), LDS_BYTES, stream, a);
#endif
}
```

```cpp
#include <hip/hip_runtime.h>
#include <cstdio>
#include <cstdint>
namespace pg8 {
#define PG8_LAS __attribute__((address_space(3)))
typedef unsigned short bf16_t;
typedef short bf16x8 __attribute__((ext_vector_type(8)));
typedef float f32x4 __attribute__((ext_vector_type(4)));
typedef unsigned u32x4 __attribute__((ext_vector_type(4)));
constexpr int BM = 256, BK = 64, HALF = 128, HTB = HALF * BK * 2  , STAGE_BYTES = 8 * HTB, NXCD = 8, WGM = 8;

__host__ __device__ __forceinline__ int lds_byte(int r, int c) { const int st = (r >> 4) * 2 + (c >> 5), rr = r & 15, cc = c & 31, ob = rr * 64 + cc * 2; return st * 1024 + (ob ^ (((ob >> 9) & 1) << 5)); }
__host__ __device__ __forceinline__ void stage_rc(int b, int& R, int& C) { const int st = b / 1024, sb = b % 1024, swz = sb ^ (((sb >> 9) & 1) << 5); R = (st >> 1) * 16 + swz / 64; C = (st & 1) * 32 + (swz % 64) / 2; }
__host__ __device__ __forceinline__ int perm32(int rho) { const int n = rho >> 4, i = rho & 15; return 8 * (i >> 2) + 4 * n + (i & 3); }

struct Unit { int pm, pn; };
struct Gemm { const bf16_t* A; const bf16_t* Bt; int M, N, K; int ld = 0; };

struct StaticOrder {
    int nM, nN, nwg, G, c;
    __host__ __device__ void init(int M, int N, int G_, int c_) { nM = M / BM; nN = N / BM; nwg = nM * nN; G = G_; c = c_; }
    __host__ __device__ bool next(int i, Unit& u) const {
        const long L = (long)i * G + c; if (L >= nwg) return false;
        int wgid = (int)L; { const int q = nwg / NXCD, r = nwg % NXCD, xcd = wgid % NXCD, off = wgid / NXCD; wgid = (xcd < r ? xcd * (q + 1) : r * (q + 1) + (xcd - r) * q) + off; }
        const int nig = WGM * nN, gid = wgid / nig, fm = gid * WGM, gsz = (nM - fm) < WGM ? (nM - fm) : WGM;
        u.pm = fm + ((wgid % nig) % gsz); u.pn = (wgid % nig) / gsz; return true;
    }
    __device__ __forceinline__ void a_ready(const Unit&) const {}
    __device__ __forceinline__ void done(const Unit&) const {}
};

__device__ __forceinline__ unsigned cvt_pk_bf16(float lo, float hi) { unsigned r; asm volatile("v_cvt_pk_bf16_f32 %0, %1, %2" : "=v"(r) : "v"(lo), "v"(hi)); return r; }

struct NatA {
    static __device__ __forceinline__ unsigned voff(int R, int C, int K) { return (unsigned)(R * K + C) * 2u; }
    static __device__ __forceinline__ size_t hstep(int K) { return (size_t)HALF * K * 2; }
    static __device__ __forceinline__ size_t tbase(int pm, int K) { return (size_t)pm * 2 * HALF * K * 2; }
};
template <class Epi, class Sched, bool ALIGN_EPI = false, bool SP2 = false, class AM = NatA>
__device__ __forceinline__ void gemm_phase(PG8_LAS unsigned char* lds, const Gemm g, const Sched& S, const Epi& E) {
    int tid_l = threadIdx.x; asm volatile("" : "+v"(tid_l));
    const int tid = tid_l, wid = __builtin_amdgcn_readfirstlane(tid >> 6), lane = tid & 63, wr = wid >> 2, wc = wid & 3, fr = lane & 15, fq = lane >> 4;
    const int K = g.ld ? g.ld : g.K, nt = g.K / BK;
    unsigned voffA[2], voffB[2];
#pragma unroll
    for (int i = 0; i < 2; ++i) { int R, C; stage_rc(tid * 16 + i * 8192, R, C); const int Rb = Epi::PERM ? ((R & ~31) + perm32(R & 31)) : R;
        voffA[i] = AM::voff(R, C, K); voffB[i] = (unsigned)(Rb * K + C) * 2u; }
    const size_t kstep = (size_t)(BK * 2);
    const size_t hstep = (size_t)HALF * K * 2;
    const size_t hstepA = AM::hstep(K);
    const size_t tstep = 2 * hstep;
    const unsigned ldsw = (unsigned)wid * 1024u;
    const int aoff = lds_byte(wr * 64 + fr, fq * 8), boff = lds_byte(wc * 32 + fr, fq * 8);
#define PG8_SA(b, h) (((b) * 2 + (h)) * HTB)
#define PG8_SB(b, h) ((4 + (b) * 2 + (h)) * HTB)
#define PG8_STAGE(bufoff, gbase, voff) do { _Pragma("unroll") for (int _i = 0; _i < 2; ++_i) \
        __builtin_amdgcn_global_load_lds((const unsigned*)((const char*)(gbase) + (voff)[_i]), (PG8_LAS unsigned*)(lds + (bufoff) + ldsw + _i * 8192), 16, 0, 0); } while (0)
#define PG8_LDA(dst, b, h) do { _Pragma("unroll") for (int m = 0; m < 4; ++m) _Pragma("unroll") for (int k = 0; k < 2; ++k) dst[m][k] = *(const PG8_LAS bf16x8*)(lds + PG8_SA(b, h) + aoff + m * 2048 + k * 1024); } while (0)
#define PG8_LDB(dst, b, h) do { _Pragma("unroll") for (int n = 0; n < 2; ++n) _Pragma("unroll") for (int k = 0; k < 2; ++k) dst[n][k] = *(const PG8_LAS bf16x8*)(lds + PG8_SB(b, h) + boff + n * 2048 + k * 1024); } while (0)
#define PG8_MMA(ai, bj, At, Bt) do { __builtin_amdgcn_s_setprio(1); _Pragma("unroll") for (int m = 0; m < 4; ++m) _Pragma("unroll") for (int n = 0; n < 2; ++n) _Pragma("unroll") for (int k = 0; k < 2; ++k) \
        acc[ai][bj][m][n] = __builtin_amdgcn_mfma_f32_16x16x32_bf16(Bt[n][k], At[m][k], acc[ai][bj][m][n], 0, 0, 0); __builtin_amdgcn_s_setprio(0); } while (0)
#define PG8_WAIT_V(n) asm volatile("s_waitcnt vmcnt(" #n ")" ::: "memory")
#define PG8_WAIT_L(n) asm volatile("s_waitcnt lgkmcnt(" #n ")" ::: "memory")
#define PG8_BAR __builtin_amdgcn_s_barrier()
#define PG8_SCHED __builtin_amdgcn_sched_barrier(0)
    Unit cur, nxt; int ui = 0;
    if (!S.next(0, cur)) return;
    f32x4 acc[2][2][4][2];
#pragma unroll
    for (int a = 0; a < 2; ++a)
#pragma unroll
        for (int b = 0; b < 2; ++b)
#pragma unroll
            for (int m = 0; m < 4; ++m)
#pragma unroll
                for (int n = 0; n < 2; ++n) acc[a][b][m][n] = (f32x4){0.f, 0.f, 0.f, 0.f};
    bf16x8 At[4][2], B0[2][2], B1[2][2];
    const char* cA = (const char*)g.A + AM::tbase(cur.pm, K); const char* cB = (const char*)g.Bt + (size_t)cur.pn * tstep;
    S.a_ready(cur);
    if constexpr (SP2) {
        PG8_STAGE(PG8_SB(0, 0), cB, voffB); PG8_STAGE(PG8_SB(0, 1), cB + hstep, voffB); PG8_STAGE(PG8_SA(0, 0), cA, voffA); PG8_STAGE(PG8_SA(0, 1), cA + hstepA, voffA);
        if (wr == 1) PG8_BAR;
        PG8_WAIT_V(2); PG8_BAR;
        PG8_STAGE(PG8_SB(1, 0), cB + kstep, voffB); PG8_STAGE(PG8_SA(1, 0), cA + kstep, voffA); PG8_STAGE(PG8_SB(1, 1), cB + hstep + kstep, voffB);
        PG8_WAIT_V(6); PG8_BAR;
    } else {
        PG8_STAGE(PG8_SB(0, 0), cB, voffB); PG8_STAGE(PG8_SA(0, 0), cA, voffA); PG8_STAGE(PG8_SB(0, 1), cB + hstep, voffB); PG8_STAGE(PG8_SA(0, 1), cA + hstepA, voffA);
        if (wr == 1) PG8_BAR;
        PG8_WAIT_V(4); PG8_BAR;
        PG8_STAGE(PG8_SB(1, 0), cB + kstep, voffB); PG8_STAGE(PG8_SA(1, 0), cA + kstep, voffA); PG8_STAGE(PG8_SB(1, 1), cB + hstep + kstep, voffB);
        PG8_WAIT_V(6); PG8_BAR;
    }
    for (;;) {
        const bool has_next = S.next(ui + 1, nxt);
        const char* nA = has_next ? (const char*)g.A + AM::tbase(nxt.pm, K) : cA; const char* nB = has_next ? (const char*)g.Bt + (size_t)nxt.pn * tstep : cB;
        for (int t = 0; t < nt; t += 2) {
            const bool last = (t == nt - 2);
            const char* a1 = cA + (size_t)(t + 1) * kstep;
            const char* a2 = last ? nA : cA + (size_t)(t + 2) * kstep; const char* b2 = last ? nB : cB + (size_t)(t + 2) * kstep;
            const char* a3 = a2 + kstep; const char* b3 = b2 + kstep;
            if (last && has_next) S.a_ready(nxt);
            if constexpr (SP2) {
            PG8_LDB(B0, 0, 0); PG8_LDB(B1, 0, 1); PG8_SCHED; PG8_LDA(At, 0, 0); PG8_STAGE(PG8_SA(1, 1), a1 + hstepA, voffA);
            PG8_WAIT_V(8); PG8_WAIT_L(0); PG8_BAR; PG8_MMA(0, 0, At, B0); PG8_MMA(0, 1, At, B1); PG8_BAR; PG8_SCHED;
            PG8_LDA(At, 0, 1); PG8_STAGE(PG8_SB(0, 0), b2, voffB); PG8_STAGE(PG8_SB(0, 1), b2 + hstep, voffB); PG8_STAGE(PG8_SA(0, 0), a2, voffA);
            PG8_WAIT_V(8); PG8_WAIT_L(0); PG8_BAR; PG8_MMA(1, 0, At, B0); PG8_MMA(1, 1, At, B1); PG8_BAR; PG8_SCHED;
            PG8_LDB(B0, 1, 0); PG8_LDB(B1, 1, 1); PG8_SCHED; PG8_LDA(At, 1, 0); PG8_STAGE(PG8_SA(0, 1), a2 + hstepA, voffA);
            PG8_WAIT_V(8); PG8_WAIT_L(0); PG8_BAR; PG8_MMA(0, 0, At, B0); PG8_MMA(0, 1, At, B1); PG8_BAR; PG8_SCHED;
            PG8_LDA(At, 1, 1); PG8_STAGE(PG8_SB(1, 0), b3, voffB); PG8_STAGE(PG8_SB(1, 1), b3 + hstep, voffB); PG8_STAGE(PG8_SA(1, 0), a3, voffA);
            PG8_WAIT_V(8); PG8_WAIT_L(0); PG8_BAR; PG8_MMA(1, 0, At, B0); PG8_MMA(1, 1, At, B1); PG8_BAR; PG8_SCHED;
            } else {
            PG8_LDB(B0, 0, 0); PG8_SCHED; PG8_LDA(At, 0, 0); PG8_STAGE(PG8_SA(1, 1), a1 + hstepA, voffA);
            PG8_WAIT_L(8); PG8_BAR; PG8_WAIT_L(0); PG8_MMA(0, 0, At, B0); PG8_BAR; PG8_SCHED;
            PG8_LDB(B1, 0, 1); PG8_STAGE(PG8_SB(0, 0), b2, voffB);
            PG8_BAR; PG8_WAIT_L(0); PG8_MMA(0, 1, At, B1); PG8_BAR;
            PG8_LDA(At, 0, 1); PG8_STAGE(PG8_SA(0, 0), a2, voffA);
            PG8_BAR; PG8_WAIT_L(0); PG8_MMA(1, 0, At, B0); PG8_BAR; PG8_SCHED;
            PG8_STAGE(PG8_SB(0, 1), b2 + hstep, voffB);
            PG8_WAIT_V(6); PG8_BAR; PG8_MMA(1, 1, At, B1); PG8_BAR;
            PG8_LDB(B0, 1, 0); PG8_SCHED; PG8_LDA(At, 1, 0); PG8_STAGE(PG8_SA(0, 1), a2 + hstepA, voffA);
            PG8_WAIT_L(8); PG8_BAR; PG8_WAIT_L(0); PG8_MMA(0, 0, At, B0); PG8_BAR; PG8_SCHED;
            PG8_LDB(B1, 1, 1); PG8_STAGE(PG8_SB(1, 0), b3, voffB);
            PG8_BAR; PG8_WAIT_L(0); PG8_MMA(0, 1, At, B1); PG8_BAR;
            PG8_LDA(At, 1, 1); PG8_STAGE(PG8_SA(1, 0), a3, voffA);
            PG8_BAR; PG8_WAIT_L(0); PG8_MMA(1, 0, At, B0); PG8_BAR; PG8_SCHED;
            PG8_STAGE(PG8_SB(1, 1), b3 + hstep, voffB);
            PG8_WAIT_V(6); PG8_BAR; PG8_MMA(1, 1, At, B1); PG8_BAR;
            }
        }
        if constexpr (ALIGN_EPI) { if (wr == 0) PG8_BAR; }
        if constexpr (!Epi::AFTER_DRAIN) { E(acc, cur, wr, wc, fr, fq); S.done(cur); }
        if (!has_next) break;
#pragma unroll
        for (int a = 0; a < 2; ++a)
#pragma unroll
            for (int b = 0; b < 2; ++b)
#pragma unroll
                for (int m = 0; m < 4; ++m)
#pragma unroll
                    for (int n = 0; n < 2; ++n) acc[a][b][m][n] = (f32x4){0.f, 0.f, 0.f, 0.f};
        cur = nxt; cA = nA; cB = nB; ++ui;
        if constexpr (ALIGN_EPI) { if (wr == 1) PG8_BAR; }
    }
    PG8_WAIT_V(0);
    if constexpr (!ALIGN_EPI) { if (wr == 0) PG8_BAR; }
    PG8_BAR;
    if constexpr (Epi::AFTER_DRAIN) { E.fused(acc, cur, wr, wc, fr, fq, lds, wid, lane); S.done(cur); }
#undef PG8_SA
#undef PG8_SB
#undef PG8_STAGE
#undef PG8_LDA
#undef PG8_LDB
#undef PG8_MMA
#undef PG8_WAIT_V
#undef PG8_WAIT_L
#undef PG8_BAR
#undef PG8_SCHED
}
}

namespace {
using pg8::bf16_t; using pg8::bf16x8; using pg8::f32x4; using pg8::u32x4; using pg8::Unit; using pg8::Gemm; using pg8::StaticOrder; using pg8::cvt_pk_bf16;
#define GAS __attribute__((address_space(1)))
#define LAS __attribute__((address_space(3)))
typedef unsigned v2u __attribute__((ext_vector_type(2)));
typedef float f32x16 __attribute__((ext_vector_type(16)));

constexpr int D = 1024, NB = 4, SEQ = 8192, TL = NB * SEQ  , CTXL = 256, TC = NB * CTXL  , TT = TL + TC  ;
constexpr int DEPTH = 4, NH = 4, DK = 128, DV = 256, CHUNK = 64, DFF = 2816, APROJ = 3088, MODW = 6 * D;
constexpr float EPS = 1e-6f;
constexpr int NWAVES = 8, NTHR = 512;

constexpr size_t MiB = 1u << 20;
constexpr size_t WS_CTL = 0, CTL_ZERO_BYTES = 2 * MiB;
constexpr int CW_BAR = 4096;
constexpr size_t WS_MOD = 1 * MiB;
constexpr size_t WS_GATES = 2 * MiB;
constexpr size_t WS_GM = 5 * MiB;
constexpr size_t WS_NST = 5 * MiB + 65536;
constexpr size_t WS_CTXRES = 7 * MiB;
constexpr size_t WS_W = 11 * MiB;
constexpr size_t W_AING = 12 * MiB;
constexpr size_t W_AIN = 0, W_AOUT = 16 * MiB, W_BIN = 20 * MiB, W_BOUT = 32 * MiB, W_UP = 36 * MiB, W_DN = 80 * MiB;
constexpr size_t WS_HX = 113 * MiB;
constexpr size_t WS_BIG = 179 * MiB;
constexpr size_t BIG_Q = 0, BIG_O = 33 * MiB, BIG_K = 99 * MiB, BIG_VT = 132 * MiB, BIG_UC = 198 * MiB;
constexpr size_t BIG_CU = 0, BIG_Z = 66 * MiB, BIG_PC = 132 * MiB;
constexpr size_t BIG_XF = 198 * MiB;
constexpr size_t BIG_CPART = 282 * MiB;
constexpr size_t BIG_A = 0, BIG_GV = 182 * MiB, BIG_GVC = 270 * MiB;
constexpr size_t WS_MODP = WS_BIG;
constexpr size_t WS_END = 509 * MiB;

constexpr int LDS_BYTES = 147456;
constexpr int MISC_OFF = LDS_BYTES - 256;

__device__ __forceinline__ float bf2f(unsigned short b) { return __uint_as_float(((unsigned)b) << 16); }
__device__ __forceinline__ float bflo(unsigned w) { return __uint_as_float(w << 16); }
__device__ __forceinline__ float bfhi(unsigned w) { return __uint_as_float(w & 0xffff0000u); }
__device__ __forceinline__ unsigned f2bf(float f) { unsigned u = __float_as_uint(f); return (u + 0x7fffu + ((u >> 16) & 1u)) >> 16; }
__device__ __forceinline__ float bfround(float f) { return __uint_as_float(f2bf(f) << 16); }
typedef __bf16 bf16v2_t __attribute__((ext_vector_type(2)));
__device__ __forceinline__ unsigned pk2(float lo, float hi) { bf16v2_t t; t.x = (__bf16)lo; t.y = (__bf16)hi; return __builtin_bit_cast(unsigned, t); }
__device__ __forceinline__ float wave_sum(float v) {
#pragma unroll
    for (int o = 1; o < 64; o <<= 1) v += __shfl_xor(v, o);
    return v;
}
__device__ __forceinline__ float wave_max(float v) {
#pragma unroll
    for (int o = 1; o < 64; o <<= 1) v = fmaxf(v, __shfl_xor(v, o));
    return v;
}
__device__ __forceinline__ float prefix_sum64(float x, int lane) {
#pragma unroll
    for (int o = 1; o < 64; o <<= 1) { const float y = __shfl_up(x, o); if (lane >= o) x += y; }
    return x;
}
__device__ __forceinline__ float prefix_max64(float x, int lane) {
#pragma unroll
    for (int o = 1; o < 64; o <<= 1) { const float y = __shfl_up(x, o); if (lane >= o) x = fmaxf(x, y); }
    return x;
}
__device__ __forceinline__ void lds_add(LAS float* p, float v) { (void)__hip_atomic_fetch_add(p, v, __ATOMIC_RELAXED, __HIP_MEMORY_SCOPE_WORKGROUP); }
__device__ __forceinline__ float sigmoidf_(float x) { return __builtin_amdgcn_rcpf(1.0f + __expf(-x)); }
__device__ __forceinline__ float siluf_(float x) { return x * __builtin_amdgcn_rcpf(1.0f + __expf(-x)); }
__device__ __forceinline__ float logsigmoidf_(float x) { const float y = __expf(-fabsf(x)); const float l = y < 0.0625f ? y * (1.0f - y * (0.5f - y * (0.33333334f - y * (0.25f - 0.2f * y)))) : __logf(1.0f + y); return fminf(x, 0.f) - l; }

__device__ __forceinline__ void unpack8(const u32x4 w, float (&f)[8]) { f[0] = bflo(w.x); f[1] = bfhi(w.x); f[2] = bflo(w.y); f[3] = bfhi(w.y); f[4] = bflo(w.z); f[5] = bfhi(w.z); f[6] = bflo(w.w); f[7] = bfhi(w.w); }

#define XB_TMO      128
#define XB_XCNT(j)  (256  + 64 * (j))
#define XB_XSUB(j)  (1280 + 64 * (j))
#define XB_XGEN(j)  (2304 + 64 * (j))
#define XB_TOP      3328
#define XB_TOPGEN   3392
#define XCD_BAR_WORDS 3456
#define XB_SPIN_CAP (1u << 18)
__device__ __forceinline__ unsigned xb_ld(unsigned* p)              { return __hip_atomic_load(p, __ATOMIC_RELAXED, __HIP_MEMORY_SCOPE_AGENT); }
__device__ __forceinline__ unsigned xb_add(unsigned* p, unsigned v) { return __hip_atomic_fetch_add(p, v, __ATOMIC_RELAXED, __HIP_MEMORY_SCOPE_AGENT); }
__device__ __forceinline__ unsigned xb_xcc_id() { return (unsigned)__builtin_amdgcn_s_getreg((3 << 11) | 20) & 0xFu; }
#define XB_SPIN(cond, bar) do { unsigned _sp = 0; while (cond) { __builtin_amdgcn_s_sleep(4); \
    if ((++_sp & 255u) == 0u) { if (xb_ld(&(bar)[XB_TMO])) break; if (_sp > XB_SPIN_CAP) { atomicAdd(&(bar)[XB_TMO], 1u); break; } } } } while (0)
struct XcdBarrier { unsigned* bar; unsigned x; volatile LAS unsigned* st; };
__device__ __forceinline__ XcdBarrier xcd_barrier_post(unsigned* bar, volatile LAS unsigned* st) {
    XcdBarrier b; b.bar = bar; b.x = xb_xcc_id(); b.st = st;
    if (threadIdx.x == 0) (void)xb_add(&bar[XB_XCNT(b.x)], 1u);
    return b;
}
__device__ __forceinline__ void xcd_barrier_complete(unsigned* bar, unsigned x, unsigned& nloc, unsigned& nx) {
    const unsigned G = gridDim.x * gridDim.y * gridDim.z;
    unsigned sum, cnt, mine, sp = 0u;
    for (;;) {
        sum = 0u; cnt = 0u; mine = 0u;
#pragma unroll
        for (unsigned j = 0; j < 16; ++j) { const unsigned c = xb_ld(&bar[XB_XCNT(j)]); sum += c; cnt += (c > 0u) ? 1u : 0u; mine = (j == x) ? c : mine; }
        if (sum == G) break;
        __builtin_amdgcn_s_sleep(1);
        if ((++sp & 255u) == 0u) { if (xb_ld(&bar[XB_TMO])) break; if (sp > XB_SPIN_CAP) { atomicAdd(&bar[XB_TMO], 1u); break; } }
    }
    nloc = mine > 0u ? mine : 1u; nx = cnt > 0u ? cnt : 1u;
}
__device__ __forceinline__ void xcd_barrier(const XcdBarrier& b) {
    asm volatile("s_waitcnt vmcnt(0)" ::: "memory");
    __syncthreads();
    if (threadIdx.x == 0) {
        unsigned* bar = b.bar;
        __builtin_amdgcn_s_waitcnt(0);
        unsigned nloc = b.st[0], nx = b.st[1];
        if (nloc == 0u) { xcd_barrier_complete(bar, b.x, nloc, nx); b.st[0] = nloc; b.st[1] = nx; }
        const unsigned old = xb_add(&bar[XB_XSUB(b.x)], 1u);
        const unsigned gen = old / nloc;
        if (old + 1u == (gen + 1u) * nloc) {
            __builtin_amdgcn_fence(__ATOMIC_RELEASE, "agent");
            asm volatile("s_waitcnt vmcnt(0)" ::: "memory");
            const unsigned og = xb_add(&bar[XB_TOP], 1u);
            const unsigned tg = og / nx;
            if (og + 1u == (tg + 1u) * nx) xb_add(&bar[XB_TOPGEN], 1u);
            else XB_SPIN(xb_ld(&bar[XB_TOPGEN]) == tg, bar);
            __builtin_amdgcn_fence(__ATOMIC_ACQUIRE, "agent");
            xb_add(&bar[XB_XGEN(b.x)], 1u);
            asm volatile("s_waitcnt vmcnt(0)" ::: "memory");
        } else {
            XB_SPIN(xb_ld(&bar[XB_XGEN(b.x)]) == gen, bar);
            __builtin_amdgcn_fence(__ATOMIC_ACQUIRE, "agent");
            asm volatile("s_waitcnt vmcnt(0)" ::: "memory");
        }
    }
    __syncthreads();
}

struct EpiStoreBf16 {
    static constexpr bool PERM = true, AFTER_DRAIN = false;
    bf16_t* O; int ldc; int split_cols; size_t split_stride;
    __device__ __forceinline__ void operator()(const f32x4 (&acc)[2][2][4][2], const Unit& u, int wr, int wc, int fr, int fq) const {
        const int row0 = u.pm * 256 + wr * 64 + fr; int colt = u.pn * 256; bf16_t* base = O;
        if (split_cols) { const int t = colt / split_cols; base += (size_t)t * split_stride; colt -= t * split_cols; }
        const int col0 = colt + wc * 32 + 8 * fq;
#pragma unroll
        for (int ai = 0; ai < 2; ++ai)
#pragma unroll
            for (int m = 0; m < 4; ++m) { bf16_t* rowp = base + (size_t)(row0 + ai * 128 + m * 16) * ldc + col0;
#pragma unroll
                for (int bj = 0; bj < 2; ++bj) { const f32x4 v0 = acc[ai][bj][m][0], v1 = acc[ai][bj][m][1];
                    u32x4 w; w.x = cvt_pk_bf16(v0[0], v0[1]); w.y = cvt_pk_bf16(v0[2], v0[3]); w.z = cvt_pk_bf16(v1[0], v1[1]); w.w = cvt_pk_bf16(v1[2], v1[3]);
                    *(u32x4*)(rowp + bj * 128) = w; } }
    }
};
struct EpiQOK {
    static constexpr bool PERM = true, AFTER_DRAIN = false;
    bf16_t *Q, *O, *K; int row_off;
    __device__ __forceinline__ void operator()(const f32x4 (&acc)[2][2][4][2], const Unit& u, int wr, int wc, int fr, int fq) const {
        bf16_t* base; int ldc, colt;
        if (u.pn < 2) { base = Q; ldc = 512; colt = u.pn * 256; } else if (u.pn < 6) { base = O; ldc = 1024; colt = (u.pn - 2) * 256; } else { base = K; ldc = 512; colt = (u.pn - 6) * 256; }
        const int row0 = row_off + u.pm * 256 + wr * 64 + fr, col0 = colt + wc * 32 + 8 * fq;
#pragma unroll
        for (int ai = 0; ai < 2; ++ai)
#pragma unroll
            for (int m = 0; m < 4; ++m) { bf16_t* rowp = base + (size_t)(row0 + ai * 128 + m * 16) * ldc + col0;
#pragma unroll
                for (int bj = 0; bj < 2; ++bj) { const f32x4 v0 = acc[ai][bj][m][0], v1 = acc[ai][bj][m][1];
                    u32x4 w; w.x = cvt_pk_bf16(v0[0], v0[1]); w.y = cvt_pk_bf16(v0[2], v0[3]); w.z = cvt_pk_bf16(v1[0], v1[1]); w.w = cvt_pk_bf16(v1[2], v1[3]);
                    *(u32x4*)(rowp + bj * 128) = w; } }
    }
};
struct ColStripA {
    static __device__ __forceinline__ unsigned voff(int R, int C, int K) { return (unsigned)(((8 * (R & 15) + ((R >> 4) & 3)) * 64 + (R >> 6)) * K + C) * 2u; }
    static __device__ __forceinline__ size_t hstep(int K) { return (size_t)256 * K * 2; }
    static __device__ __forceinline__ size_t tbase(int pm, int K) { return (size_t)((pm >> 5) * SEQ + 2 * (pm & 31)) * K * 2; }
};
__device__ __forceinline__ f32x4 dpp_prev(const f32x4 x) { f32x4 r;
#pragma unroll
    for (int j = 0; j < 4; ++j) r[j] = __int_as_float(__builtin_amdgcn_update_dpp(0, __float_as_int(x[j]), 0x111, 0xf, 0xf, true));
    return r; }
__device__ __forceinline__ f32x4 dpp_next(const f32x4 x) { f32x4 r;
#pragma unroll
    for (int j = 0; j < 4; ++j) r[j] = __int_as_float(__builtin_amdgcn_update_dpp(0, __float_as_int(x[j]), 0x101, 0xf, 0xf, true));
    return r; }
constexpr float LOG2E_ = 1.4426950408889634f;
struct EpiConvGLU {
    static constexpr bool PERM = true, AFTER_DRAIN = false;
    bf16_t* Aout; const float* wconv  ; const float* bconv  ;
    __device__ __forceinline__ void operator()(const f32x4 (&acc)[2][2][4][2], const Unit& u, int wr, int wc, int fr, int fq) const {
        const int ch0 = u.pn * 128 + wc * 32 + 8 * fq;
        const size_t tok0 = (size_t)(u.pm >> 5) * SEQ + 2 * (u.pm & 31) + wr;
        f32x4 w0[2], w1[2], w2[2], bb[2];
#pragma unroll
        for (int n = 0; n < 2; ++n) { w0[n] = *(const f32x4*)(wconv + ch0 + 4 * n); w1[n] = *(const f32x4*)(wconv + DFF + ch0 + 4 * n); w2[n] = *(const f32x4*)(wconv + 2 * DFF + ch0 + 4 * n); bb[n] = *(const f32x4*)(bconv + ch0 + 4 * n); }
#pragma unroll
        for (int s = 0; s < 8; ++s) {
            const int ai = s >> 2, m = s & 3;
            u32x4 w;
#pragma unroll
            for (int n = 0; n < 2; ++n) {
                const f32x4 gp = s > 0 ? acc[(s - 1) >> 2][0][(s - 1) & 3][n] : dpp_prev(acc[1][0][3][n]);
                const f32x4 gn = s < 7 ? acc[(s + 1) >> 2][0][(s + 1) & 3][n] : dpp_next(acc[0][0][0][n]);
                const f32x4 t = w0[n] * gp + w1[n] * acc[ai][0][m][n] + w2[n] * gn + bb[n];
                const f32x4 tm = t * (-LOG2E_); f32x4 ex, rc;
#pragma unroll
                for (int j = 0; j < 4; ++j) ex[j] = __builtin_amdgcn_exp2f(tm[j]);
                const f32x4 den = ex + 1.0f;
#pragma unroll
                for (int j = 0; j < 4; ++j) rc[j] = __builtin_amdgcn_rcpf(den[j]);
                const f32x4 o = (t * rc) * acc[ai][1][m][n];
                if (n == 0) { w.x = pk2(o[0], o[1]); w.y = pk2(o[2], o[3]); } else { w.z = pk2(o[0], o[1]); w.w = pk2(o[2], o[3]); }
            }
            *(u32x4*)(Aout + (tok0 + (size_t)(8 * fr + s) * 64) * DFF + ch0) = w;
        }
    }
};
struct SeqStripA {
    static __device__ __forceinline__ unsigned voff(int R, int C, int K) { return (unsigned)((128 * (R >> 6) + 8 * (R & 15) + ((R >> 4) & 3)) * K + C) * 2u; }
    static __device__ __forceinline__ size_t hstep(int K) { return (size_t)4 * K * 2; }
    static __device__ __forceinline__ size_t tbase(int pm, int K) { return (size_t)pm * 256 * K * 2; }
};
struct EpiConvU {
    static constexpr bool PERM = true, AFTER_DRAIN = false;
    bf16_t* CU; const float* wconv  ;
    __device__ __forceinline__ void operator()(const f32x4 (&acc)[2][2][4][2], const Unit& u, int wr, int wc, int fr, int fq) const {
        const int ch0 = u.pn * 128 + wc * 32 + 8 * fq;
        const size_t tok0 = (size_t)u.pm * 256 + 128 * wr + 8 * fr;
        const bool first = (fr & 7) == 0, last = (fr & 7) == 7;
        f32x4 w0[2], w1[2], w2[2];
#pragma unroll
        for (int n = 0; n < 2; ++n) { w0[n] = *(const f32x4*)(wconv + ch0 + 4 * n); w1[n] = *(const f32x4*)(wconv + D + ch0 + 4 * n); w2[n] = *(const f32x4*)(wconv + 2 * D + ch0 + 4 * n); }
        f32x4 pv[2], nx[2];
#pragma unroll
        for (int n = 0; n < 2; ++n) { pv[n] = dpp_prev(acc[1][0][3][n] * acc[1][1][3][n]); nx[n] = dpp_next(acc[0][0][0][n] * acc[0][1][0][n]);
            if (first) pv[n] = (f32x4){0.f, 0.f, 0.f, 0.f}; if (last) nx[n] = (f32x4){0.f, 0.f, 0.f, 0.f}; }
#pragma unroll
        for (int s = 0; s < 8; ++s) {
            u32x4 w;
#pragma unroll
            for (int n = 0; n < 2; ++n) {
                const f32x4 up = s > 0 ? acc[(s - 1) >> 2][0][(s - 1) & 3][n] * acc[(s - 1) >> 2][1][(s - 1) & 3][n] : pv[n];
                const f32x4 un = s < 7 ? acc[(s + 1) >> 2][0][(s + 1) & 3][n] * acc[(s + 1) >> 2][1][(s + 1) & 3][n] : nx[n];
                const f32x4 o = w0[n] * up + w1[n] * (acc[s >> 2][0][s & 3][n] * acc[s >> 2][1][s & 3][n]) + w2[n] * un;
                if (n == 0) { w.x = pk2(o[0], o[1]); w.y = pk2(o[2], o[3]); } else { w.z = pk2(o[0], o[1]); w.w = pk2(o[2], o[3]); }
            }
            *(u32x4*)(CU + (tok0 + s) * D + ch0) = w;
        }
    }
};
struct EpiMulZ {
    static constexpr bool PERM = true, AFTER_DRAIN = false;
    const bf16_t* CU; bf16_t* Z;
    __device__ __forceinline__ void operator()(const f32x4 (&acc)[2][2][4][2], const Unit& u, int wr, int wc, int fr, int fq) const {
        const int row0 = u.pm * 256 + wr * 64 + fr, col0 = u.pn * 256 + wc * 32 + 8 * fq;
        u32x4 cur[2], nxt[2];
#pragma unroll
        for (int bj = 0; bj < 2; ++bj) cur[bj] = *(const u32x4*)(CU + (size_t)row0 * D + col0 + bj * 128);
#pragma unroll
        for (int g = 0; g < 8; ++g) { const int ai = g >> 2, m = g & 3; const size_t off = (size_t)(row0 + ai * 128 + m * 16) * D + col0;
            if (g < 7) { const size_t offn = (size_t)(row0 + ((g + 1) >> 2) * 128 + ((g + 1) & 3) * 16) * D + col0;
#pragma unroll
                for (int bj = 0; bj < 2; ++bj) nxt[bj] = *(const u32x4*)(CU + offn + bj * 128); }
#pragma unroll
            for (int bj = 0; bj < 2; ++bj) { float c[8]; unpack8(cur[bj], c); const f32x4 v0 = acc[ai][bj][m][0], v1 = acc[ai][bj][m][1];
                u32x4 w; w.x = pk2(v0[0] * c[0], v0[1] * c[1]); w.y = pk2(v0[2] * c[2], v0[3] * c[3]); w.z = pk2(v1[0] * c[4], v1[1] * c[5]); w.w = pk2(v1[2] * c[6], v1[3] * c[7]);
                *(u32x4*)(Z + off + bj * 128) = w; cur[bj] = nxt[bj]; }
        }
    }
};
template <bool BASEF32, bool OUTBF> struct EpiResidual {
    static constexpr bool PERM = true, AFTER_DRAIN = false;
    const void* base; void* out; const float* gate0; int gdiv;
    __device__ __forceinline__ void ldb(size_t off, f32x4 (&d)[2][2]) const {
        if (BASEF32) {
#pragma unroll
            for (int bj = 0; bj < 2; ++bj)
#pragma unroll
                for (int n = 0; n < 2; ++n) d[bj][n] = *(const f32x4*)((const float*)base + off + bj * 128 + n * 4);
        } else {
#pragma unroll
            for (int bj = 0; bj < 2; ++bj) { const u32x4 w = *(const u32x4*)((const bf16_t*)base + off + bj * 128);
                d[bj][0] = (f32x4){bflo(w.x), bfhi(w.x), bflo(w.y), bfhi(w.y)}; d[bj][1] = (f32x4){bflo(w.z), bfhi(w.z), bflo(w.w), bfhi(w.w)}; }
        }
    }
    __device__ __forceinline__ void operator()(const f32x4 (&acc)[2][2][4][2], const Unit& u, int wr, int wc, int fr, int fq) const {
        const int row0 = u.pm * 256 + wr * 64 + fr, col0 = u.pn * 256 + wc * 32 + 8 * fq;
        const float* gp = gate0 + (size_t)(u.pm / gdiv) * MODW + col0;
        f32x4 gv[2][2], cur[2][2], nxt[2][2];
#pragma unroll
        for (int bj = 0; bj < 2; ++bj)
#pragma unroll
            for (int n = 0; n < 2; ++n) gv[bj][n] = *(const f32x4*)(gp + bj * 128 + n * 4);
        ldb((size_t)row0 * D + col0, cur);
#pragma unroll
        for (int g = 0; g < 8; ++g) { const int ai = g >> 2, m = g & 3; const size_t off = (size_t)(row0 + ai * 128 + m * 16) * D + col0;
            if (g < 7) ldb((size_t)(row0 + ((g + 1) >> 2) * 128 + ((g + 1) & 3) * 16) * D + col0, nxt);
#pragma unroll
            for (int bj = 0; bj < 2; ++bj) { f32x4 x[2];
#pragma unroll
                for (int n = 0; n < 2; ++n) { x[n] = cur[bj][n] + gv[bj][n] * acc[ai][bj][m][n]; cur[bj][n] = nxt[bj][n]; }
                if (OUTBF) { u32x4 w; w.x = pk2(x[0][0], x[0][1]); w.y = pk2(x[0][2], x[0][3]); w.z = pk2(x[1][0], x[1][1]); w.w = pk2(x[1][2], x[1][3]); *(u32x4*)((bf16_t*)out + off + bj * 128) = w; }
                else { *(f32x4*)((float*)out + off + bj * 128) = x[0]; *(f32x4*)((float*)out + off + bj * 128 + 4) = x[1]; } }
        }
    }
};

template <class Epi, class AM = pg8::NatA>
__device__ __forceinline__ void run_gemm(LAS unsigned char* lds, const bf16_t* A, const bf16_t* Bt, int M, int N, int K, const Epi& E, int boff = 0) {
    Gemm g{A, Bt, M, N, K}; StaticOrder S; const int G = (int)gridDim.x; S.init(M, N, G, ((int)blockIdx.x + G - boff) % G);
    pg8::gemm_phase<Epi, StaticOrder, true, true, AM>(lds, g, S, E);
}

template <class Epi>
__device__ __forceinline__ void run_gemm_slice(LAS unsigned char* lds, const bf16_t* A, const bf16_t* Bt, int M, int N, int k0, int Ks, int ld, int boff, const Epi& E) {
    Gemm g{A + k0, Bt + k0, M, N, Ks, ld}; StaticOrder S; const int G = (int)gridDim.x; S.init(M, N, G, ((int)blockIdx.x + G - boff) % G);
    pg8::gemm_phase<Epi, StaticOrder, true, true>(lds, g, S, E);
}
struct EpiPartF32 {
    static constexpr bool PERM = false, AFTER_DRAIN = false;
    float* Pout;
    __device__ __forceinline__ void operator()(const f32x4 (&acc)[2][2][4][2], const Unit& u, int wr, int wc, int fr, int fq) const {
        const int row0 = u.pm * 256 + wr * 64 + fr, col0 = u.pn * 256 + wc * 32 + 4 * fq;
#pragma unroll
        for (int ai = 0; ai < 2; ++ai)
#pragma unroll
            for (int m = 0; m < 4; ++m) { float* rp = Pout + (size_t)(row0 + ai * 128 + m * 16) * D + col0;
#pragma unroll
                for (int bj = 0; bj < 2; ++bj)
#pragma unroll
                    for (int n = 0; n < 2; ++n) *(f32x4*)(rp + bj * 128 + n * 16) = acc[ai][bj][m][n]; }
    }
};
struct EpiVT {
    static constexpr bool PERM = true, AFTER_DRAIN = false;
    bf16_t* VT; int tok0;
    __device__ __forceinline__ void operator()(const f32x4 (&acc)[2][2][4][2], const Unit& u, int wr, int wc, int fr, int fq) const {
        const int f0 = u.pm * 256 + wr * 64 + fr, r0 = tok0 + u.pn * 256 + wc * 32 + 8 * fq;
#pragma unroll
        for (int ai = 0; ai < 2; ++ai)
#pragma unroll
            for (int m = 0; m < 4; ++m) { const int f = f0 + ai * 128 + m * 16, h = f >> 8, vb = (f & 255) >> 5, vl = f & 31;
#pragma unroll
                for (int bj = 0; bj < 2; ++bj) { const int r = r0 + bj * 128, tb = r >> 7, ks = (r & 127) >> 4, hh = (r >> 3) & 1;
                    const f32x4 v0 = acc[ai][bj][m][0], v1 = acc[ai][bj][m][1];
                    u32x4 w; w.x = cvt_pk_bf16(v0[0], v0[1]); w.y = cvt_pk_bf16(v0[2], v0[3]); w.z = cvt_pk_bf16(v1[0], v1[1]); w.w = cvt_pk_bf16(v1[2], v1[3]);
                    *(u32x4*)(VT + ((size_t)((((tb * 4 + h) * 8 + vb) * 8 + ks) * 2 + hh) * 32 + vl) * 8) = w; } }
    }
};
struct EpiGates {
    static constexpr bool PERM = false, AFTER_DRAIN = false;
    float* GT; const float* bgate; int row0;
    __device__ __forceinline__ void operator()(const f32x4 (&acc)[2][2][4][2], const Unit& u, int wr, int wc, int fr, int fq) const {
        if (wc != 0) return;
        const int r0 = row0 + u.pm * 256 + wr * 64 + fr;
        const f32x4 bg = *(const f32x4*)(bgate + 4 * fq);
#pragma unroll
        for (int ai = 0; ai < 2; ++ai)
#pragma unroll
            for (int m = 0; m < 4; ++m) { const int row = r0 + ai * 128 + m * 16; const f32x4 a = acc[ai][0][m][0] + acc[ai][0][m][1] + bg;
#pragma unroll
                for (int j = 0; j < 4; ++j) GT[(size_t)(4 * fq + j) * TT + row] = fq < 2 ? a[j] : logsigmoidf_(a[j]); }
    }
};

__device__ __forceinline__ void transpose_item(const float* W, int ld, int K, int k0, int n0src, bf16_t* WT, int row0dst, float scale, LAS float* scr, int lane) {
#pragma unroll 8
    for (int i = 0; i < 32; ++i) { const int kk = 2 * i + (lane >> 5); scr[kk * 33 + (lane & 31)] = W[(size_t)(k0 + kk) * ld + n0src + (lane & 31)] * scale; }
    asm volatile("s_waitcnt lgkmcnt(0)" ::: "memory");
    const int c = lane & 7;
#pragma unroll
    for (int j = 0; j < 4; ++j) { const int n = (lane >> 3) + 8 * j; const LAS float* s = scr + (8 * c) * 33 + n;
        u32x4 o; o.x = pk2(s[0 * 33], s[1 * 33]); o.y = pk2(s[2 * 33], s[3 * 33]); o.z = pk2(s[4 * 33], s[5 * 33]); o.w = pk2(s[6 * 33], s[7 * 33]);
        *(u32x4*)(WT + (size_t)(row0dst + n) * K + k0 + 8 * c) = o; }
    asm volatile("s_waitcnt lgkmcnt(0)" ::: "memory");
}
struct Ptrs {
    const float *x, *c, *ctx, *c_ctx, *w_mod, *b_mod, *g_mix, *g_ffn, *a_w_in, *a_b_gate, *a_head_gain, *a_w_out, *b_w_in, *b_w_conv, *b_w_out, *f_w_up, *f_w_conv, *f_b_conv, *f_w_down, *g_final;
    float* out; unsigned char* ws;
};
__device__ __forceinline__ void p0_convert(const Ptrs& P, LAS unsigned char* lds, int wave, int lane) {
    LAS float* scr = (LAS float*)(lds + wave * 16384);
    const int gw = blockIdx.x * NWAVES + wave, NGW = gridDim.x * NWAVES;
    constexpr int I_AIN = 16 * 96, I_AOUT = 16 * 32, I_BIN = 16 * 96, I_BOUT = 16 * 32, I_UP = 16 * 176, I_DN = 44 * 32;
    constexpr int S0 = 2 * I_AIN, S1 = S0 + 2 * I_AOUT, S2 = S1 + 2 * I_BIN, S3 = S2 + 2 * I_BOUT, S4 = S3 + 4 * I_UP, S5 = S4 + 4 * I_DN;
    bf16_t* WB = (bf16_t*)(P.ws + WS_W);
    for (int it = gw; it < S5; it += NGW) {
        if (it < S0) { const int j = it / I_AIN, r = it % I_AIN, kb = r / 96, ng = r % 96;
            const int drow = ng < 16 ? 32 * ng : ng < 32 ? 1536 + 32 * (ng - 16) : ng < 64 ? 2048 + 32 * (ng - 32) : 512 + 32 * (ng - 64);
            transpose_item(P.a_w_in + (size_t)j * D * APROJ, APROJ, D, 64 * kb, 32 * ng, WB + (W_AIN / 2) + (size_t)j * 3072 * D, drow, (ng >= 16 && ng < 32) ? 0.08838834764831845f : 1.0f, scr, lane);
        } else if (it < S1) { const int q = it - S0, j = q / I_AOUT, r = q % I_AOUT, kb = r / 32, ng = r % 32;
            transpose_item(P.a_w_out + (size_t)j * D * D, D, D, 64 * kb, 32 * ng, WB + (W_AOUT / 2) + (size_t)j * D * D, 32 * ng, 1.0f, scr, lane);
        } else if (it < S2) { const int q = it - S1, j = q / I_BIN, r = q % I_BIN, kb = r / 96, ng = r % 96;
            const int c0 = 32 * (ng & 31), drow = ng < 32 ? 2048 + c0 : 256 * (c0 >> 7) + (c0 & 127) + (ng < 64 ? 0 : 128);
            transpose_item(P.b_w_in + (size_t)j * D * 3 * D, 3 * D, D, 64 * kb, 32 * ng, WB + (W_BIN / 2) + (size_t)j * 3 * D * D, drow, 1.0f, scr, lane);
        } else if (it < S3) { const int q = it - S2, j = q / I_BOUT, r = q % I_BOUT, kb = r / 32, ng = r % 32;
            transpose_item(P.b_w_out + (size_t)j * D * D, D, D, 64 * kb, 32 * ng, WB + (W_BOUT / 2) + (size_t)j * D * D, 32 * ng, 1.0f, scr, lane);
        } else if (it < S4) { const int q = it - S3, i = q / I_UP, r = q % I_UP, kb = r / 176, ng = r % 176;
            const int c0 = 32 * (ng < 88 ? ng : ng - 88), drow = 256 * (c0 >> 7) + (c0 & 127) + (ng < 88 ? 0 : 128);
            transpose_item(P.f_w_up + (size_t)i * D * 2 * DFF, 2 * DFF, D, 64 * kb, 32 * ng, WB + (W_UP / 2) + (size_t)i * 2 * DFF * D, drow, 1.0f, scr, lane);
        } else { const int q = it - S4, i = q / I_DN, r = q % I_DN, kb = r / 32, ng = r % 32;
            transpose_item(P.f_w_down + (size_t)i * DFF * D, D, DFF, 64 * kb, 32 * ng, WB + (W_DN / 2) + (size_t)i * D * DFF, 32 * ng, 1.0f, scr, lane);
        }
    }
}
__device__ __forceinline__ void p0_mod(const Ptrs& P, LAS unsigned char* lds, int tid) {
    LAS float* s = (LAS float*)lds;
    for (int i = tid; i < 5 * D; i += NTHR) { const int b = i >> 10, k = i & 1023; const float v = b < 4 ? P.c[b * D + k] : P.c_ctx[k]; s[i] = v / (1.0f + __expf(-v)); }
    __syncthreads();
    float* MODP = (float*)(P.ws + WS_MODP);
    for (int u = blockIdx.x; u < DEPTH * 16 * 12; u += gridDim.x) {
        const int i = u / 192, r = u % 192, ks = r / 12, nb = r % 12, n = nb * 512 + tid;
        const float* w = P.w_mod + ((size_t)i * D + 64 * ks) * MODW + n;
        float a0 = 0.f, a1 = 0.f, a2 = 0.f, a3 = 0.f, a4 = 0.f;
#pragma unroll 8
        for (int k = 0; k < 64; ++k) { const float wv = w[(size_t)k * MODW]; const int kk = 64 * ks + k;
            a0 += s[kk] * wv; a1 += s[D + kk] * wv; a2 += s[2 * D + kk] * wv; a3 += s[3 * D + kk] * wv; a4 += s[4 * D + kk] * wv; }
        float* o = MODP + ((size_t)ks * DEPTH + i) * 5 * MODW + n;
        o[0] = a0; o[MODW] = a1; o[2 * MODW] = a2; o[3 * MODW] = a3; o[4 * MODW] = a4;
    }
}
__device__ __forceinline__ void mod_reduce(const Ptrs& P, int tid) {
    const float* MODP = (const float*)(P.ws + WS_MODP); float* MOD = (float*)(P.ws + WS_MOD);
    for (int e = blockIdx.x * NTHR + tid; e < DEPTH * 5 * MODW; e += gridDim.x * NTHR) {
        const int i = e / (5 * MODW), n = e % MODW; float a = P.b_mod[i * MODW + n];
#pragma unroll
        for (int ks = 0; ks < 16; ++ks) a += MODP[(size_t)ks * DEPTH * 5 * MODW + e];
        MOD[e] = a;
    }
}
#define NC0(j) (512 * ((j) >> 1) + 8 * lane + 4 * ((j) & 1))
template <bool GATES, bool BF16IN>
__device__ __forceinline__ void norm_phase(const float* xl, const float* xc, float* xco, const float* cpart, int ncp, const float* cgate, int nrows, const float* g, const float* modl  , int sh_off, int sc_off, bf16_t* HX,
                                           const float* wg  , const float* bgate, float* GT, LAS unsigned char* lds, int tid, int wave, int lane) {
    LAS float* wl = (LAS float*)lds;
    if (GATES) { for (int i = tid; i < 16 * D; i += NTHR) { const int k = i >> 4, gi = i & 15; wl[gi * D + k] = wg[(size_t)k * APROJ + gi]; } __syncthreads(); }
    const int gw = blockIdx.x * NWAVES + wave, NGW = gridDim.x * NWAVES;
    const int RPW = (TL + NGW - 1) / NGW, r0 = gw * RPW, nl = r0 < TL ? (TL - r0 < RPW ? TL - r0 : RPW) : 0;
    int bcur = -1; f32x4 gsv[4], shv[4];
    int idx0 = 0;
    if (!GATES && BF16IN) {
        for (; idx0 + 4 <= nl; idx0 += 4) {
            const int row = r0 + idx0, b = row >> 13;
            if (b != bcur) { bcur = b; const float* mb = modl + (size_t)b * MODW;
#pragma unroll
                for (int j = 0; j < 4; ++j) { const int c0 = NC0(j); gsv[j] = *(const f32x4*)(g + c0) * (*(const f32x4*)(mb + sc_off + c0) + 1.0f); shv[j] = *(const f32x4*)(mb + sh_off + c0); } }
            const bf16_t* xbr = (const bf16_t*)xl + (size_t)row * D;
            u32x4 w[4][2];
#pragma unroll
            for (int r = 0; r < 4; ++r)
#pragma unroll
                for (int jj = 0; jj < 2; ++jj) w[r][jj] = *(const u32x4*)(xbr + (size_t)r * D + NC0(2 * jj));
            asm volatile("" ::: "memory");
#pragma unroll
            for (int r = 0; r < 4; ++r) {
                f32x4 v[4]; float ss = 0.f;
#pragma unroll
                for (int jj = 0; jj < 2; ++jj) { const u32x4 q = w[r][jj]; v[2 * jj] = (f32x4){bflo(q.x), bfhi(q.x), bflo(q.y), bfhi(q.y)}; v[2 * jj + 1] = (f32x4){bflo(q.z), bfhi(q.z), bflo(q.w), bfhi(q.w)}; }
#pragma unroll
                for (int j = 0; j < 4; ++j) ss += (v[j][0] * v[j][0] + v[j][1] * v[j][1]) + (v[j][2] * v[j][2] + v[j][3] * v[j][3]);
                const float rstd = rsqrtf(wave_sum(ss) * (1.0f / D) + EPS);
#pragma unroll
                for (int j = 0; j < 4; ++j) v[j] = (v[j] * rstd) * gsv[j] + shv[j];
#pragma unroll
                for (int jj = 0; jj < 2; ++jj) { u32x4 o; o.x = pk2(v[2 * jj][0], v[2 * jj][1]); o.y = pk2(v[2 * jj][2], v[2 * jj][3]); o.z = pk2(v[2 * jj + 1][0], v[2 * jj + 1][1]); o.w = pk2(v[2 * jj + 1][2], v[2 * jj + 1][3]);
                    *(u32x4*)(HX + (size_t)(row + r) * D + NC0(2 * jj)) = o; }
            }
        }
    }
    if (!GATES && !BF16IN) {
        f32x4 gsf[4], shf[4]; int bc2 = -1;
        for (; idx0 + 2 <= nl; idx0 += 2) {
            const int row = r0 + idx0, b = row >> 13;
            if (b != bc2) { bc2 = b; const float* mb = modl + (size_t)b * MODW;
#pragma unroll
                for (int q = 0; q < 4; ++q) { const int c0 = 256 * q + 4 * lane; gsf[q] = *(const f32x4*)(g + c0) * (*(const f32x4*)(mb + sc_off + c0) + 1.0f); shf[q] = *(const f32x4*)(mb + sh_off + c0); } }
            f32x4 v[2][4];
#pragma unroll
            for (int r = 0; r < 2; ++r)
#pragma unroll
                for (int q = 0; q < 4; ++q) v[r][q] = *(const f32x4*)(xl + (size_t)(row + r) * D + 256 * q + 4 * lane);
            asm volatile("" ::: "memory");
#pragma unroll
            for (int r = 0; r < 2; ++r) {
                float ss = 0.f;
#pragma unroll
                for (int q = 0; q < 4; ++q) ss += (v[r][q][0] * v[r][q][0] + v[r][q][1] * v[r][q][1]) + (v[r][q][2] * v[r][q][2] + v[r][q][3] * v[r][q][3]);
                const float rstd = rsqrtf(wave_sum(ss) * (1.0f / D) + EPS);
#pragma unroll
                for (int q = 0; q < 4; ++q) { const f32x4 y = (v[r][q] * rstd) * gsf[q] + shf[q]; v2u o; o.x = pk2(y[0], y[1]); o.y = pk2(y[2], y[3]);
                    *(v2u*)(HX + (size_t)(row + r) * D + 256 * q + 4 * lane) = o; }
            }
        }
    }
    for (int idx = idx0;; ++idx) {
        const int row = idx < nl ? r0 + idx : TL + gw + (idx - nl) * NGW;
        if (row >= nrows) break;
        const float* xr = row < TL ? xl + (size_t)row * D : xc + (size_t)(row - TL) * D;
        const int b = row < TL ? (row >> 13) : 4;
        if (b != bcur) { bcur = b; const float* mb = modl + (size_t)b * MODW;
#pragma unroll
            for (int j = 0; j < 4; ++j) { const int c0 = NC0(j); gsv[j] = *(const f32x4*)(g + c0) * (*(const f32x4*)(mb + sc_off + c0) + 1.0f); shv[j] = *(const f32x4*)(mb + sh_off + c0); } }
        f32x4 v[4]; float ss = 0.f;
        if (BF16IN && row < TL) { const bf16_t* xbr = (const bf16_t*)xl + (size_t)row * D;
#pragma unroll
            for (int jj = 0; jj < 2; ++jj) { const u32x4 w = *(const u32x4*)(xbr + NC0(2 * jj)); v[2 * jj] = (f32x4){bflo(w.x), bfhi(w.x), bflo(w.y), bfhi(w.y)}; v[2 * jj + 1] = (f32x4){bflo(w.z), bfhi(w.z), bflo(w.w), bfhi(w.w)}; }
        } else {
#pragma unroll
            for (int j = 0; j < 4; ++j) v[j] = *(const f32x4*)(xr + NC0(j)); }
        if (ncp > 0 && row >= TL) {
#pragma unroll
            for (int j = 0; j < 4; ++j) { const int c0 = NC0(j); f32x4 s = *(const f32x4*)(cpart + (size_t)(row - TL) * D + c0);
                for (int p = 1; p < ncp; ++p) s = s + *(const f32x4*)(cpart + ((size_t)p * TC + (row - TL)) * D + c0);
                v[j] = v[j] + *(const f32x4*)(cgate + c0) * s; *(f32x4*)(xco + (size_t)(row - TL) * D + c0) = v[j]; } }
#pragma unroll
        for (int j = 0; j < 4; ++j) ss += (v[j][0] * v[j][0] + v[j][1] * v[j][1]) + (v[j][2] * v[j][2] + v[j][3] * v[j][3]);
        const float rstd = rsqrtf(wave_sum(ss) * (1.0f / D) + EPS);
#pragma unroll
        for (int j = 0; j < 4; ++j) v[j] = (v[j] * rstd) * gsv[j] + shv[j];
#pragma unroll
        for (int jj = 0; jj < 2; ++jj) { u32x4 o; o.x = pk2(v[2 * jj][0], v[2 * jj][1]); o.y = pk2(v[2 * jj][2], v[2 * jj][3]); o.z = pk2(v[2 * jj + 1][0], v[2 * jj + 1][1]); o.w = pk2(v[2 * jj + 1][2], v[2 * jj + 1][3]);
            *(u32x4*)(HX + (size_t)row * D + NC0(2 * jj)) = o; }
        if (GATES) {
            float p[16];
#pragma unroll
            for (int gi = 0; gi < 16; ++gi) { float a = 0.f;
#pragma unroll
                for (int j = 0; j < 4; ++j) { const f32x4 w = *(const LAS f32x4*)(wl + gi * D + NC0(j)); a += (v[j][0] * w[0] + v[j][1] * w[1]) + (v[j][2] * w[2] + v[j][3] * w[3]); }
                p[gi] = a; asm volatile("" ::: "memory"); }
#pragma unroll
            for (int i = 0; i < 8; ++i) { const bool up = lane & 1; const float keep = up ? p[2 * i + 1] : p[2 * i], send = up ? p[2 * i] : p[2 * i + 1]; p[i] = keep + __shfl_xor(send, 1); }
#pragma unroll
            for (int i = 0; i < 4; ++i) { const bool up = lane & 2; const float keep = up ? p[2 * i + 1] : p[2 * i], send = up ? p[2 * i] : p[2 * i + 1]; p[i] = keep + __shfl_xor(send, 2); }
#pragma unroll
            for (int i = 0; i < 2; ++i) { const bool up = lane & 4; const float keep = up ? p[2 * i + 1] : p[2 * i], send = up ? p[2 * i] : p[2 * i + 1]; p[i] = keep + __shfl_xor(send, 4); }
            { const bool up = lane & 8; const float keep = up ? p[1] : p[0], send = up ? p[0] : p[1]; p[0] = keep + __shfl_xor(send, 8); }
            float tot = p[0]; tot += __shfl_xor(tot, 16); tot += __shfl_xor(tot, 32);
            if (lane < 16) { const float pre = tot + bgate[lane]; GT[(size_t)lane * TT + row] = lane < 8 ? pre : logsigmoidf_(pre); }
        }
    }
}
#undef NC0
__device__ __forceinline__ void final_norm(const bf16_t* xb, float* out, const float* g, int wave, int lane) {
    const int gw = blockIdx.x * NWAVES + wave, NGW = gridDim.x * NWAVES;
    const int RPW = (TL + NGW - 1) / NGW, r0 = gw * RPW, r1 = r0 + RPW < TL ? r0 + RPW : TL;
    f32x4 gg[4];
#pragma unroll
    for (int q = 0; q < 4; ++q) gg[q] = *(const f32x4*)(g + 256 * q + 4 * lane);
    int row = r0;
    for (; row + 4 <= r1; row += 4) {
        v2u w[4][4];
#pragma unroll
        for (int r = 0; r < 4; ++r)
#pragma unroll
            for (int q = 0; q < 4; ++q) w[r][q] = *(const v2u*)(xb + (size_t)(row + r) * D + 256 * q + 4 * lane);
        asm volatile("" ::: "memory");
#pragma unroll
        for (int r = 0; r < 4; ++r) { f32x4 v[4]; float ss = 0.f;
#pragma unroll
            for (int q = 0; q < 4; ++q) { v[q] = (f32x4){bflo(w[r][q].x), bfhi(w[r][q].x), bflo(w[r][q].y), bfhi(w[r][q].y)}; ss += (v[q][0] * v[q][0] + v[q][1] * v[q][1]) + (v[q][2] * v[q][2] + v[q][3] * v[q][3]); }
            const float rstd = rsqrtf(wave_sum(ss) * (1.0f / D) + EPS);
#pragma unroll
            for (int q = 0; q < 4; ++q) *(f32x4*)(out + (size_t)(row + r) * D + 256 * q + 4 * lane) = (v[q] * rstd) * gg[q]; }
    }
    for (; row < r1; ++row) { f32x4 v[4]; float ss = 0.f;
#pragma unroll
        for (int q = 0; q < 4; ++q) { const v2u w = *(const v2u*)(xb + (size_t)row * D + 256 * q + 4 * lane); v[q] = (f32x4){bflo(w.x), bfhi(w.x), bflo(w.y), bfhi(w.y)}; ss += (v[q][0] * v[q][0] + v[q][1] * v[q][1]) + (v[q][2] * v[q][2] + v[q][3] * v[q][3]); }
        const float rstd = rsqrtf(wave_sum(ss) * (1.0f / D) + EPS);
#pragma unroll
        for (int q = 0; q < 4; ++q) *(f32x4*)(out + (size_t)row * D + 256 * q + 4 * lane) = (v[q] * rstd) * gg[q]; }
}
__device__ __forceinline__ void shortconv_ctx_phase(const bf16_t* Pc, bf16_t* Z, const float* wc  , int tid) {
    const long total = (long)TC * (D / 8);
    for (long it = (long)blockIdx.x * NTHR + tid; it < total; it += (long)gridDim.x * NTHR) {
        const int row = (int)(it >> 7), c0 = (int)(it & 127) * 8, t = row & 255;
        const bool hasl = t != 0, hasr = t != 255;
        const bf16_t* pr = Pc + (size_t)row * 3 * D + 256 * (c0 >> 7) + (c0 & 127);
        float bg[8], u0[8], um[8], up[8], a[8], b[8];
        unpack8(*(const u32x4*)(Pc + (size_t)row * 3 * D + 2048 + c0), bg);
        unpack8(*(const u32x4*)pr, a); unpack8(*(const u32x4*)(pr + 128), b);
#pragma unroll
        for (int j = 0; j < 8; ++j) u0[j] = a[j] * b[j];
        if (hasl) { unpack8(*(const u32x4*)(pr - 3 * D), a); unpack8(*(const u32x4*)(pr - 3 * D + 128), b);
#pragma unroll
            for (int j = 0; j < 8; ++j) um[j] = a[j] * b[j]; } else {
#pragma unroll
            for (int j = 0; j < 8; ++j) um[j] = 0.f; }
        if (hasr) { unpack8(*(const u32x4*)(pr + 3 * D), a); unpack8(*(const u32x4*)(pr + 3 * D + 128), b);
#pragma unroll
            for (int j = 0; j < 8; ++j) up[j] = a[j] * b[j]; } else {
#pragma unroll
            for (int j = 0; j < 8; ++j) up[j] = 0.f; }
        float z[8];
#pragma unroll
        for (int j = 0; j < 8; ++j) z[j] = bg[j] * (wc[c0 + j] * um[j] + wc[D + c0 + j] * u0[j] + wc[2 * D + c0 + j] * up[j]);
        u32x4 o; o.x = pk2(z[0], z[1]); o.y = pk2(z[2], z[3]); o.z = pk2(z[4], z[5]); o.w = pk2(z[6], z[7]);
        *(u32x4*)(Z + (size_t)row * D + c0) = o;
    }
}
__device__ __forceinline__ void act_phase(const bf16_t* GV, bf16_t* Aout, const float* wc  , const float* bc  , int nrows, bool is_ctx, int tid) {
    const long total = (long)nrows * (DFF / 8);
    for (long it = (long)blockIdx.x * NTHR + tid; it < total; it += (long)gridDim.x * NTHR) {
        const int row = (int)(it / (DFF / 8)), c0 = (int)(it % (DFF / 8)) * 8;
        bool hasl, hasr; int S;
        if (!is_ctx) { const int r = (row & 8191) >> 6; hasl = r != 0; hasr = r != 127; S = 64; } else { const int t = row & 255; hasl = t != 0; hasr = t != 255; S = 1; }
        const bf16_t* pr = GV + (size_t)row * 2 * DFF + 256 * (c0 >> 7) + (c0 & 127);
        float g0[8], gm[8], gp[8], vv[8];
        unpack8(*(const u32x4*)pr, g0); unpack8(*(const u32x4*)(pr + 128), vv);
        if (hasl) unpack8(*(const u32x4*)(pr - (size_t)S * 2 * DFF), gm); else {
#pragma unroll
            for (int j = 0; j < 8; ++j) gm[j] = 0.f; }
        if (hasr) unpack8(*(const u32x4*)(pr + (size_t)S * 2 * DFF), gp); else {
#pragma unroll
            for (int j = 0; j < 8; ++j) gp[j] = 0.f; }
        float z[8];
#pragma unroll
        for (int j = 0; j < 8; ++j) { const float gt = wc[c0 + j] * gm[j] + wc[DFF + c0 + j] * g0[j] + wc[2 * DFF + c0 + j] * gp[j] + bc[c0 + j]; z[j] = siluf_(gt) * vv[j]; }
        u32x4 o; o.x = pk2(z[0], z[1]); o.y = pk2(z[2], z[3]); o.z = pk2(z[4], z[5]); o.w = pk2(z[6], z[7]);
        *(u32x4*)(Aout + (size_t)row * DFF + c0) = o;
    }
}

constexpr int SCL = 128, NSC = 2 + SEQ / SCL  , NCH = NB * NH * 2  ;
__device__ __forceinline__ int sc_row0(int b, int sc) { return sc < 2 ? TL + b * CTXL + sc * SCL : b * SEQ + (sc - 2) * SCL; }
constexpr float LOG2E = 1.4426950408889634f;
constexpr int QKW = NH * DK;
constexpr int LD136 = 136;
constexpr int HS_LD = 264;

struct GateScan { int tok0, tok1; float gi0, gi1, bc0, bc1, g; };
__device__ __forceinline__ GateScan gate_scan(const float* GT, int dir, int h, int grow0, int lane) {
    GateScan s; s.tok0 = dir ? 127 - 2 * lane : 2 * lane; s.tok1 = dir ? 126 - 2 * lane : 2 * lane + 1;
    const float* gi = GT + (size_t)(dir * 4 + h) * TT + grow0; const float* gf = GT + (size_t)(8 + dir * 4 + h) * TT + grow0;
    s.gi0 = gi[s.tok0]; s.gi1 = gi[s.tok1]; const float f0 = gf[s.tok0], f1 = gf[s.tok1];
    const float incl = prefix_sum64(f0 + f1, lane);
    s.bc0 = incl - f1; s.bc1 = incl; s.g = __shfl(incl, 63);
    return s;
}

__device__ __forceinline__ void mlstm_p1(LAS unsigned char* lds, const bf16_t* Kb, const bf16_t* VT, const float* GT, bf16_t* UC, float* GM, float* NST, int tid, int wave, int lane) {
    LAS float* s_wa = (LAS float*)lds;
    LAS bf16_t* img[2] = {(LAS bf16_t*)(lds + 2048), (LAS bf16_t*)(lds + 2048 + 128 * LD136 * 2)};
    const int l31 = lane & 31, hh = lane >> 5;
    for (int u = blockIdx.x; u < NB * NH * NSC; u += gridDim.x) {
        const int sc = u % NSC, bh = u / NSC, h = bh & 3, b = bh >> 2;
        const int row0 = sc_row0(b, sc);
        const int v = 32 * wave + l31;
        bf16x8 vt[8];
#pragma unroll
        for (int ks = 0; ks < 8; ++ks) vt[ks] = *(const bf16x8*)(VT + ((size_t)(((((row0 >> 7) * 4 + h) * 8 + wave) * 8 + ks) * 2 + hh) * 32 + l31) * 8);
        if (wave < 2) {
            const int dir = wave; const GateScan s = gate_scan(GT, dir, h, row0, lane);
            const float a0 = s.g - s.bc0 + s.gi0, a1 = s.g - s.bc1 + s.gi1, mloc = wave_max(fmaxf(a0, a1));
            s_wa[dir * 128 + s.tok0] = __expf(a0 - mloc); s_wa[dir * 128 + s.tok1] = __expf(a1 - mloc);
            if (lane == 0) { float* gm = GM + ((size_t)((b * 4 + h) * 2 + dir) * NSC + sc) * 4; gm[0] = s.g; gm[1] = mloc; }
        }
        __syncthreads();
#pragma unroll
        for (int k = 0; k < 2; ++k) {
            const int s2 = tid & 63, d8 = ((tid >> 6) + 8 * k) * 8;
            float k0[8], k1[8];
            unpack8(*(const u32x4*)(Kb + (size_t)(row0 + 2 * s2) * QKW + h * DK + d8), k0); unpack8(*(const u32x4*)(Kb + (size_t)(row0 + 2 * s2 + 1) * QKW + h * DK + d8), k1);
#pragma unroll
            for (int dir = 0; dir < 2; ++dir) { const float w0 = s_wa[dir * 128 + 2 * s2], w1 = s_wa[dir * 128 + 2 * s2 + 1];
#pragma unroll
                for (int j = 0; j < 8; ++j) *(LAS unsigned*)(img[dir] + (d8 + j) * LD136 + 2 * s2) = pk2(k0[j] * w0, k1[j] * w1); }
        }
        __syncthreads();
        if (tid < 256) {
            const int dir = tid >> 7, d = tid & 127; float sum = 0.f;
#pragma unroll
            for (int k8 = 0; k8 < 16; ++k8) { float f[8]; unpack8(*(const LAS u32x4*)(img[dir] + d * LD136 + 8 * k8), f);
#pragma unroll
                for (int j = 0; j < 8; ++j) sum += f[j]; }
            NST[((size_t)((b * 4 + h) * 2 + dir) * NSC + sc) * DK + d] = sum;
        }
#pragma unroll
        for (int dir = 0; dir < 2; ++dir) {
            bf16_t* up = UC + ((size_t)((b * 4 + h) * 2 + dir) * NSC + sc) * DV * DK + (wave * 16 * 32 + l31) * 8 + 4 * hh;
#pragma unroll
            for (int dt = 0; dt < 4; ++dt) {
                f32x16 acc;
#pragma unroll
                for (int r = 0; r < 16; ++r) acc[r] = 0.f;
#pragma unroll
                for (int ks = 0; ks < 8; ++ks) { const bf16x8 a = *(const LAS bf16x8*)(img[dir] + (32 * dt + l31) * LD136 + 16 * ks + 8 * hh);
                    acc = __builtin_amdgcn_mfma_f32_32x32x16_bf16(a, vt[ks], acc, 0, 0, 0); }
#pragma unroll
                for (int i4 = 0; i4 < 4; ++i4) { v2u o; o.x = pk2(acc[4 * i4], acc[4 * i4 + 1]); o.y = pk2(acc[4 * i4 + 2], acc[4 * i4 + 3]);
                    *(v2u*)(up + ((4 * (dt & 1) + i4) * 2 + (dt >> 1)) * 256) = o; }
            }
        }
        __syncthreads();
    }
}
typedef float f32x2_t __attribute__((ext_vector_type(2)));
__device__ __forceinline__ void mlstm_p2(bf16_t* UC, float* GM, float* NST, int tid) {
    for (int item = blockIdx.x * NTHR + tid; item < NCH * 8192; item += gridDim.x * NTHR) {
        const int ch = item >> 13, e = item & 8191, dir = ch & 1;
        float c0 = 0.f, c1 = 0.f, c2 = 0.f, c3 = 0.f, nn = 0.f, m = 0.f;
        for (int st = 0; st < NSC; st += 6) {
            v2u uu[6]; float gg[6], ml[6], un[6]; int scs[6];
#pragma unroll
            for (int k = 0; k < 6; ++k) { const int s = st + k; const int sc = dir == 0 ? s : (s < 2 ? 1 - s : NSC + 1 - s); scs[k] = sc;
                const size_t ci = (size_t)ch * NSC + sc;
                uu[k] = *(const v2u*)(UC + ci * (DV * DK) + (size_t)e * 4); { const f32x2_t gm2 = *(const f32x2_t*)(GM + ci * 4); gg[k] = gm2.x; ml[k] = gm2.y; }
                un[k] = e < DK ? NST[ci * DK + e] : 0.f; }
#pragma unroll
            for (int k = 0; k < 6; ++k) { const size_t ci = (size_t)ch * NSC + scs[k];
                const float mn = fmaxf(gg[k] + m, ml[k]), dec = __expf(gg[k] + m - mn), sc = __expf(ml[k] - mn);
                v2u o; o.x = pk2(c0, c1); o.y = pk2(c2, c3);
                *(v2u*)(UC + ci * (DV * DK) + (size_t)e * 4) = o;
                if (e < DK) NST[ci * DK + e] = nn;
                if (e == 0) GM[ci * 4 + 2] = m;
                c0 = dec * c0 + sc * bflo(uu[k].x); c1 = dec * c1 + sc * bfhi(uu[k].x); c2 = dec * c2 + sc * bflo(uu[k].y); c3 = dec * c3 + sc * bfhi(uu[k].y);
                nn = dec * nn + sc * un[k]; m = mn; }
        }
    }
}
__device__ __forceinline__ void mlstm_p3(LAS unsigned char* lds, const bf16_t* Qb, const bf16_t* Ob, const bf16_t* Kb, const bf16_t* VT, const bf16_t* UC, const float* GM, const float* NST,
                                         const float* GT, const float* gain, bf16_t* HN, bool emit_ctx, int tid, int wave, int lane) {
    LAS float* s_bc = (LAS float*)lds;
    LAS float* s_ii = s_bc + 256;
    LAS float* s_mt = s_ii + 256;
    LAS float* s_wi = s_mt + 256;
    LAS float* s_r = s_wi + 256;
    LAS float* s_n0 = s_r + 128;
    LAS bf16_t* Qi = (LAS bf16_t*)(lds + 8192);
    LAS bf16_t* Ki = Qi + 64 * LD136;
    LAS bf16_t* Wi[2] = {Ki + 128 * LD136, Ki + 128 * LD136 + 64 * LD136};
    LAS bf16_t* Qp[2] = {Wi[1] + 64 * LD136, Wi[1] + 128 * LD136};
    LAS float* Hs = (LAS float*)(lds + 8192 + (64 + 128) * LD136 * 2);
    LAS float* s_dp = (LAS float*)(lds + 130048);
    const int l31 = lane & 31, hh = lane >> 5, l15 = lane & 15, q4 = lane >> 4;
    const int nsq = emit_ctx ? NSC : NSC - 2, nun = NB * NH * nsq;
    const int G = (int)gridDim.x, bid = (int)blockIdx.x, nfu = nun / G, tail = nun - nfu * G; const bool split = 2 * tail <= G;
    const int nvis = nfu + (split ? (bid < 2 * tail ? 1 : 0) : (bid < tail ? 1 : 0));
#define P3_VISIT(k, U, HLO) const int U = (k) < nfu ? bid + G * (k) : nfu * G + (split ? (bid >> 1) : bid), HLO = ((k) >= nfu && split) ? (bid & 1) : 0;
    if (nvis > 0) {
        P3_VISIT(0, u, hlo)
        const int sc = (u % nsq) + (emit_ctx ? 0 : 2), bh = u / nsq, h = bh & 3, b = bh >> 2, srow0 = sc_row0(b, sc);
#pragma unroll
        for (int k = 0; k < 4; ++k) { const int q = tid + NTHR * k, r = q >> 4, c8 = (q & 15) * 8;
            *(LAS u32x4*)(Ki + r * LD136 + c8) = *(const u32x4*)(Kb + (size_t)(srow0 + r) * QKW + h * DK + c8); }
#pragma unroll
        for (int k = 0; k < 2; ++k) { const int q = tid + NTHR * k, r = q >> 4, c8 = (q & 15) * 8;
            *(LAS u32x4*)(Qi + r * LD136 + c8) = *(const u32x4*)(Qb + (size_t)(srow0 + 64 * hlo + r) * QKW + h * DK + c8); }
    }
    for (int vk = 0; vk < nvis; ++vk) {
        P3_VISIT(vk, u, hlo)
        const int hhi = (vk >= nfu && split) ? hlo + 1 : 2;
        const int sc = (u % nsq) + (emit_ctx ? 0 : 2), bh = u / nsq, h = bh & 3, b = bh >> 2;
        const int srow0 = sc_row0(b, sc);
        const int chF = (b * 4 + h) * 2;
        const int v = 32 * wave + l31;
        const bool has_next = vk + 1 < nvis;
        P3_VISIT(vk + 1, un, hlon)
        const int scn = (un % nsq) + (emit_ctx ? 0 : 2), bhn = un / nsq, hn = bhn & 3;
        const int srow0n = has_next ? sc_row0(bhn >> 2, scn) : srow0;
        int tl = tid; asm volatile("" : "+v"(tl));
        if (wave < 2) {
            const int dir = wave; const GateScan s = gate_scan(GT, dir, h, srow0, lane);
            const float m0 = GM[((size_t)(chF + dir) * NSC + sc) * 4 + 2];
            const float e0 = s.gi0 - s.bc0, e1 = s.gi1 - s.bc1;
            const float pmx = prefix_max64(fmaxf(e0, e1), lane); float exm = __shfl_up(pmx, 1); if (lane == 0) exm = -3.0e38f;
            const float pm0 = fmaxf(exm, e0), pm1 = pmx;
            s_bc[dir * 128 + s.tok0] = (s.gi0 - s.bc0) * LOG2E; s_bc[dir * 128 + s.tok1] = (s.gi1 - s.bc1) * LOG2E;
            { const float mt = s.bc0 + fmaxf(m0, pm0); s_mt[dir * 128 + s.tok0] = mt; s_ii[dir * 128 + s.tok0] = (s.bc0 - mt) * LOG2E; s_wi[dir * 128 + s.tok0] = __expf(s.bc0 + m0 - mt); }
            { const float mt = s.bc1 + fmaxf(m0, pm1); s_mt[dir * 128 + s.tok1] = mt; s_ii[dir * 128 + s.tok1] = (s.bc1 - mt) * LOG2E; s_wi[dir * 128 + s.tok1] = __expf(s.bc1 + m0 - mt); }
        } else if (wave < 6) { const int i = tid - 128, dir = i >> 7, d = i & 127; s_n0[i] = NST[((size_t)(chF + dir) * NSC + sc) * DK + d]; }
#pragma unroll 1
        for (int half = hlo; half < hhi; ++half) {
            const int qrow0 = srow0 + 64 * half;
            int th = tl; asm volatile("" : "+v"(th));
            const int tid = th, lane = th & 63, l31 = lane & 31, hh = lane >> 5, l15 = lane & 15, q4 = lane >> 4, v = 32 * wave + l31;
            __syncthreads();
            {
                const int kb = wave >> 1, qb = wave & 1;
                f32x16 sacc;
#pragma unroll
                for (int r = 0; r < 16; ++r) sacc[r] = 0.f;
#pragma unroll
                for (int ks = 0; ks < 8; ++ks) { const bf16x8 a = *(const LAS bf16x8*)(Ki + (32 * kb + l31) * LD136 + 16 * ks + 8 * hh), bq = *(const LAS bf16x8*)(Qi + (32 * qb + l31) * LD136 + 16 * ks + 8 * hh);
                    sacc = __builtin_amdgcn_mfma_f32_32x32x16_bf16(a, bq, sacc, 0, 0, 0); }
                const int t = 32 * qb + l31, tg = 64 * half + t;
                const int rel = kb - (2 * half + qb);
#pragma unroll
                for (int dir = 0; dir < 2; ++dir) {
                    const bool zero = dir == 0 ? rel > 0 : rel < 0, full = dir == 0 ? rel < 0 : rel > 0;
                    if (zero) {
#pragma unroll
                        for (int r4 = 0; r4 < 4; ++r4) { v2u o; o.x = 0u; o.y = 0u; *(LAS v2u*)(Wi[dir] + t * LD136 + 32 * kb + 8 * r4 + 4 * hh) = o; }
                        if (hh == 0) { s_dp[(dir * 64 + t) * 9 + 2 * kb] = 0.f; s_dp[(dir * 64 + t) * 9 + 2 * kb + 1] = 0.f; }
                    } else {
                        const float qq = s_ii[dir * 128 + tg]; float part[2] = {0.f, 0.f};
#pragma unroll
                        for (int r4 = 0; r4 < 4; ++r4) { const int s0 = 32 * kb + 8 * r4 + 4 * hh;
                            const f32x4 kq = *(const LAS f32x4*)(s_bc + dir * 128 + s0); float ev[4];
#pragma unroll
                            for (int j = 0; j < 4; ++j) ev[j] = __builtin_amdgcn_exp2f(qq + kq[j]);
                            if (!full) {
#pragma unroll
                                for (int j = 0; j < 4; ++j) { const int sx = s0 + j; const bool ok = dir == 0 ? (sx <= tg) : (sx >= tg); ev[j] = ok ? ev[j] : 0.f; } }
                            v2u o; o.x = pk2(ev[0] * sacc[4 * r4], ev[1] * sacc[4 * r4 + 1]); o.y = pk2(ev[2] * sacc[4 * r4 + 2], ev[3] * sacc[4 * r4 + 3]);
                            *(LAS v2u*)(Wi[dir] + t * LD136 + s0) = o;
                            part[r4 >> 1] += (bflo(o.x) + bfhi(o.x)) + (bflo(o.y) + bfhi(o.y)); }
                        part[0] += __shfl_xor(part[0], 32); part[1] += __shfl_xor(part[1], 32);
                        if (hh == 0) { s_dp[(dir * 64 + t) * 9 + 2 * kb] = part[0]; s_dp[(dir * 64 + t) * 9 + 2 * kb + 1] = part[1]; }
                    }
                }
            }
            { const int dir = tid >> 8, t = (tid >> 2) & 63, part = tid & 3; float qn = 0.f;
#pragma unroll
              for (int k = 0; k < 4; ++k) { float qf[8]; unpack8(*(const LAS u32x4*)(Qi + t * LD136 + 32 * part + 8 * k), qf);
                  const f32x4 na = *(const LAS f32x4*)(s_n0 + dir * 128 + 32 * part + 8 * k), nb = *(const LAS f32x4*)(s_n0 + dir * 128 + 32 * part + 8 * k + 4);
                  qn += (qf[0] * na[0] + qf[1] * na[1]) + (qf[2] * na[2] + qf[3] * na[3]) + (qf[4] * nb[0] + qf[5] * nb[1]) + (qf[6] * nb[2] + qf[7] * nb[3]); }
              qn += __shfl_xor(qn, 1); qn += __shfl_xor(qn, 2);
              if (part == 0) s_dp[(dir * 64 + t) * 9 + 8] = qn * s_wi[dir * 128 + 64 * half + t]; }
            bf16x8 cf[2][8];
#pragma unroll
            for (int dir = 0; dir < 2; ++dir)
#pragma unroll
                for (int ks = 0; ks < 8; ++ks) cf[dir][ks] = *(const bf16x8*)(UC + ((size_t)(chF + dir) * NSC + sc) * DV * DK + (((wave * 8 + ks) * 2 + hh) * 32 + l31) * 8);
            __syncthreads();
            if (tid < 128) { float den = 0.f;
#pragma unroll
                for (int q = 0; q < 9; ++q) den += s_dp[tid * 9 + q];
                s_r[tid] = 1.0f / fmaxf(fabsf(den), __expf(-s_mt[(tid >> 6) * 128 + 64 * half + (tid & 63)])); }
            const bool same = half + 1 < hhi, pfq = same || has_next, pfk = !same && has_next;
            u32x4 pq[2], pk[4];
            { const int nrow0 = same ? srow0 + 64 * (half + 1) : srow0n + 64 * hlon, nh = same ? h : hn;
              if (pfq) {
#pragma unroll
                  for (int k = 0; k < 2; ++k) { const int q = tl + NTHR * k, r = q >> 4, c8 = (q & 15) * 8; pq[k] = *(const u32x4*)(Qb + (size_t)(nrow0 + r) * QKW + nh * DK + c8); } }
              if (pfk) {
#pragma unroll
                  for (int k = 0; k < 4; ++k) { const int q = tl + NTHR * k, r = q >> 4, c8 = (q & 15) * 8; pk[k] = *(const u32x4*)(Kb + (size_t)(srow0n + r) * QKW + hn * DK + c8); } } }
            asm volatile("" ::: "memory");
            f32x16 acc[2][2];
#pragma unroll
            for (int dir = 0; dir < 2; ++dir)
#pragma unroll
                for (int tt = 0; tt < 2; ++tt)
#pragma unroll
                    for (int r = 0; r < 16; ++r) acc[dir][tt][r] = 0.f;
            bf16x8 vt[8];
#pragma unroll
            for (int ks = 0; ks < 8; ++ks) {
#pragma unroll
                for (int tt = 0; tt < 2; ++tt) { const bf16x8 a = *(const LAS bf16x8*)(Qi + (32 * tt + l31) * LD136 + 64 * hh + 8 * ks);
                    acc[0][tt] = __builtin_amdgcn_mfma_f32_32x32x16_bf16(a, cf[0][ks], acc[0][tt], 0, 0, 0);
                    acc[1][tt] = __builtin_amdgcn_mfma_f32_32x32x16_bf16(a, cf[1][ks], acc[1][tt], 0, 0, 0); }
                vt[ks] = *(const bf16x8*)(VT + ((size_t)(((((srow0 >> 7) * 4 + h) * 8 + wave) * 8 + ks) * 2 + hh) * 32 + l31) * 8);
                asm volatile("" ::: "memory");
            }
#pragma unroll
            for (int dir = 0; dir < 2; ++dir)
#pragma unroll
                for (int tt = 0; tt < 2; ++tt)
#pragma unroll
                    for (int r4 = 0; r4 < 4; ++r4) { const f32x4 wv = *(const LAS f32x4*)(s_wi + dir * 128 + 64 * half + 32 * tt + 8 * r4 + 4 * hh);
#pragma unroll
                        for (int j = 0; j < 4; ++j) acc[dir][tt][4 * r4 + j] *= wv[j]; }
            asm volatile("" ::: "memory");
#pragma unroll
            for (int dir = 0; dir < 2; ++dir)
#pragma unroll
                for (int tt = 0; tt < 2; ++tt)
#pragma unroll
                    for (int ks = 0; ks < 8; ++ks) { const bf16x8 a = *(const LAS bf16x8*)(Wi[dir] + (32 * tt + l31) * LD136 + 16 * ks + 8 * hh);
                        acc[dir][tt] = __builtin_amdgcn_mfma_f32_32x32x16_bf16(a, vt[ks], acc[dir][tt], 0, 0, 0); }
            __syncthreads();
            if (pfq) {
#pragma unroll
                for (int k = 0; k < 2; ++k) { const int q = tl + NTHR * k, r = q >> 4, c8 = (q & 15) * 8; *(LAS u32x4*)(Qi + r * LD136 + c8) = pq[k]; } }
            if (pfk) {
#pragma unroll
                for (int k = 0; k < 4; ++k) { const int q = tl + NTHR * k, r = q >> 4, c8 = (q & 15) * 8; *(LAS u32x4*)(Ki + r * LD136 + c8) = pk[k]; } }
#pragma unroll
            for (int tt = 0; tt < 2; ++tt)
#pragma unroll
                for (int r4 = 0; r4 < 4; ++r4) { const int t0 = 32 * tt + 8 * r4 + 4 * hh; const f32x4 rf = *(const LAS f32x4*)(s_r + t0), rb = *(const LAS f32x4*)(s_r + 64 + t0);
#pragma unroll
                    for (int j = 0; j < 4; ++j) Hs[(t0 + j) * HS_LD + v] = rf[j] * acc[0][tt][4 * r4 + j] + rb[j] * acc[1][tt][4 * r4 + j]; }
            u32x4 ov[4];
#pragma unroll
            for (int k4 = 0; k4 < 4; ++k4) ov[k4] = *(const u32x4*)(Ob + (size_t)(qrow0 + (tl >> 3)) * D + h * DV + 64 * k4 + 8 * (tl & 7));
            __syncthreads();
            { const int t = tid >> 3, seg = tid & 7;
              f32x4 hq[8]; float ss = 0.f;
#pragma unroll
              for (int k = 0; k < 8; ++k) { hq[k] = *(const LAS f32x4*)(Hs + t * HS_LD + 64 * (k >> 1) + 8 * seg + 4 * (k & 1)); ss += (hq[k][0] * hq[k][0] + hq[k][1] * hq[k][1]) + (hq[k][2] * hq[k][2] + hq[k][3] * hq[k][3]); }
              ss += __shfl_xor(ss, 1); ss += __shfl_xor(ss, 2); ss += __shfl_xor(ss, 4);
              const float rstd = rsqrtf(ss * (1.0f / DV) + EPS);
              bf16_t* op = HN + (size_t)(qrow0 + t) * D + h * DV + 8 * seg;
#pragma unroll
              for (int k4 = 0; k4 < 4; ++k4) { float of[8]; unpack8(ov[k4], of); float y[8];
                  const f32x4 ga = *(const f32x4*)(gain + h * DV + 64 * k4 + 8 * seg), gb = *(const f32x4*)(gain + h * DV + 64 * k4 + 8 * seg + 4);
#pragma unroll
                  for (int j = 0; j < 8; ++j) { const int c = 8 * k4 + j; y[j] = hq[c >> 2][c & 3] * (rstd * (j < 4 ? ga[j & 3] : gb[j & 3])) * sigmoidf_(of[j]); }
                  u32x4 w; w.x = pk2(y[0], y[1]); w.y = pk2(y[2], y[3]); w.z = pk2(y[4], y[5]); w.w = pk2(y[6], y[7]);
                  *(u32x4*)(op + 64 * k4) = w; } }
            __syncthreads();
        }
    }
}
#undef P3_VISIT
}

#ifndef MK_MULTI
#define MK_MULTI 0
#endif
struct Args { Ptrs p; int ph_lo, ph_hi; };
constexpr int PH_MLSTM = 6, PH_SCONV = 4;
constexpr int NPHASES = 2 + 2 * (PH_MLSTM + PH_SCONV) + (4 + 4 + 3 + 3) + 1;

__global__ void __launch_bounds__(NTHR, 2) fwd_kernel(Args args) {
    extern __shared__ __attribute__((aligned(16))) unsigned char lds_raw[];
    LAS unsigned char* lds = (LAS unsigned char*)lds_raw;
    const Ptrs& P = args.p;
    volatile LAS unsigned* MISC = (volatile LAS unsigned*)(lds + MISC_OFF);
    if (threadIdx.x < 32) MISC[threadIdx.x] = 0u;
    __syncthreads();
    unsigned* ctl = (unsigned*)(P.ws + WS_CTL);
    XcdBarrier bar; bar.bar = ctl + CW_BAR; bar.x = 0; bar.st = nullptr;
    if (!MK_MULTI) bar = xcd_barrier_post(ctl + CW_BAR, MISC + 8);
    const int lo = args.ph_lo, hi = args.ph_hi;
    int ph = 0;
#define PH_BEGIN if (ph >= lo && ph < hi) { int tid_l = threadIdx.x; asm volatile("" : "+v"(tid_l)); const int tid = tid_l, lane = tid & 63, wave = __builtin_amdgcn_readfirstlane(tid >> 6); (void)lane; (void)wave;
#define PH_END   if (ph + 1 < hi) xcd_barrier(bar); else { asm volatile("s_waitcnt vmcnt(0)" ::: "memory"); __syncthreads(); } } ++ph;

    unsigned char* ws = P.ws;
    float* MOD = (float*)(ws + WS_MOD);
    float* GT = (float*)(ws + WS_GATES);
    float* GM = (float*)(ws + WS_GM);
    float* NST = (float*)(ws + WS_NST);
    float* CTXRES = (float*)(ws + WS_CTXRES);
    bf16_t* WB = (bf16_t*)(ws + WS_W);
    bf16_t* HX = (bf16_t*)(ws + WS_HX);
    unsigned char* BIG = ws + WS_BIG;
    bf16_t* XB = (bf16_t*)P.out;
    bf16_t* XF = (bf16_t*)(BIG + BIG_XF);
    float* CPART = (float*)(BIG + BIG_CPART);

    PH_BEGIN
        p0_convert(P, lds, wave, lane);
        __syncthreads();
        p0_mod(P, lds, tid);
        {
            bf16_t* WG = WB + W_AING / 2;
            for (int e = blockIdx.x * NTHR + tid; e < 2 * 256 * D; e += gridDim.x * NTHR) {
                const int j = e >> 18, n = (e >> 10) & 255, k = e & 1023; float w = 0.f;
                if (n < 32) { const float f = P.a_w_in[((size_t)j * D + k) * APROJ + 3072 + (n & 15)]; const float hi = bfround(f); w = n < 16 ? hi : f - hi; }
                WG[e] = (bf16_t)f2bf(w);
            }
        }
    PH_END
    PH_BEGIN
        mod_reduce(P, tid);
    PH_END

#pragma unroll 1
    for (int lp = 0; lp < 2; ++lp) {
        {
            const int i = 2 * lp, j = lp;
            const float* xc = i == 0 ? P.ctx : CTXRES;
            const float* modl = MOD + (size_t)i * 5 * MODW;
            const bool emit_ctx = i == 0;
            bf16_t* Qb = (bf16_t*)(BIG + BIG_Q); bf16_t* Ob = (bf16_t*)(BIG + BIG_O); bf16_t* Kb = (bf16_t*)(BIG + BIG_K); bf16_t* VT = (bf16_t*)(BIG + BIG_VT); bf16_t* UC = (bf16_t*)(BIG + BIG_UC);
            const bf16_t* Wain = WB + W_AIN / 2 + (size_t)j * 3072 * D;
            PH_BEGIN
if (i == 0) norm_phase<false, false>(P.x, xc, CTXRES, CPART, 0, MOD, TT, P.g_mix + (size_t)i * D, modl, 0, D, HX, nullptr, nullptr, nullptr, lds, tid, wave, lane); else norm_phase<false, true>((const float*)XB, xc, CTXRES, CPART, 4, MOD + (size_t)(i - 1) * 5 * MODW + 4 * MODW + 5 * D, TT, P.g_mix + (size_t)i * D, modl, 0, D, HX, nullptr, nullptr, nullptr, lds, tid, wave, lane);
            PH_END
            PH_BEGIN
                {
                    EpiQOK E{Qb, Ob, Kb, 0};
                    run_gemm(lds, HX, Wain, TL, 2048, D, E);
                    EpiQOK Ec{Qb, Ob, Kb, TL};
                    run_gemm(lds, HX + (size_t)TL * D, Wain, TC, 2048, D, Ec);
                }
                {
                    EpiVT E{VT, 0};
                    run_gemm(lds, Wain + (size_t)2048 * D, HX, 1024, TL, D, E);
                    EpiVT Ec{VT, TL};
                    run_gemm(lds, Wain + (size_t)2048 * D, HX + (size_t)TL * D, 1024, TC, D, Ec, 240);
                }
                {
                    const bf16_t* Wg = WB + W_AING / 2 + (size_t)j * 256 * D;
                    EpiGates Eg{GT, P.a_b_gate + j * 16, 0};
                    run_gemm(lds, HX, Wg, TL, 256, D, Eg, 32);
                    EpiGates Egc{GT, P.a_b_gate + j * 16, TL};
                    run_gemm(lds, HX + (size_t)TL * D, Wg, TC, 256, D, Egc, 160);
                }
            PH_END
            PH_BEGIN
mlstm_p1(lds, Kb, VT, GT, UC, GM, NST, tid, wave, lane);
            PH_END
            PH_BEGIN
                mlstm_p2(UC, GM, NST, tid);
            PH_END
            PH_BEGIN
mlstm_p3(lds, Qb, Ob, Kb, VT, UC, GM, NST, GT, P.a_head_gain + (size_t)j * D, HX, emit_ctx, tid, wave, lane);
            PH_END
            PH_BEGIN
                {
                    if (i == 0) { EpiResidual<true, true> E{P.x, XB, modl + 2 * D, 32}; run_gemm(lds, HX, WB + W_AOUT / 2 + (size_t)j * D * D, TL, D, D, E); }
                    else { EpiResidual<false, true> E{XB, XB, modl + 2 * D, 32}; run_gemm(lds, HX, WB + W_AOUT / 2 + (size_t)j * D * D, TL, D, D, E); }
                    if (emit_ctx) {
                        EpiPartF32 E0{CPART}, E1{CPART + (size_t)TC * D};
                        run_gemm_slice(lds, HX + (size_t)TL * D, WB + W_AOUT / 2 + (size_t)j * D * D, TC, D, 0, 512, D, 0, E0);
                        run_gemm_slice(lds, HX + (size_t)TL * D, WB + W_AOUT / 2 + (size_t)j * D * D, TC, D, 512, 512, D, 128, E1); }
                }
            PH_END
        }
#pragma unroll 1
        for (int sub = 0; sub < 2; ++sub) {
            const int i = 2 * lp + sub;
            const float* modl = MOD + (size_t)i * 5 * MODW;
            const bool ctx_live = i < 2;
            if (sub == 1) {
                const int j = lp;
                bf16_t* CU = (bf16_t*)(BIG + BIG_CU); bf16_t* Z = (bf16_t*)(BIG + BIG_Z); bf16_t* Pc = (bf16_t*)(BIG + BIG_PC);
                const bf16_t* Wbin = WB + W_BIN / 2 + (size_t)j * 3 * D * D;
                const int nrows = ctx_live ? TT : TL;
                PH_BEGIN
norm_phase<false, true>((const float*)XB, CTXRES, CTXRES, CPART, ctx_live ? 4 : 0, MOD + (size_t)(i - 1) * 5 * MODW + 4 * MODW + 5 * D, nrows, P.g_mix + (size_t)i * D, modl, 0, D, HX, nullptr, nullptr, nullptr, lds, tid, wave, lane);
                PH_END
                PH_BEGIN
{ EpiConvU E{CU, P.b_w_conv + (size_t)j * 3 * D}; run_gemm<EpiConvU, SeqStripA>(lds, HX, Wbin, TL, 2 * D, D, E); }
                    if (ctx_live) { EpiStoreBf16 Ec{Pc, 3 * D, 0, 0}; run_gemm(lds, HX + (size_t)TL * D, Wbin, TC, 3 * D, D, Ec); }
                PH_END
                PH_BEGIN
{ EpiMulZ E{CU, Z}; run_gemm(lds, HX, Wbin + (size_t)2 * D * D, TL, D, D, E); }
                    if (ctx_live) shortconv_ctx_phase(Pc, Z + (size_t)TL * D, P.b_w_conv + (size_t)j * 3 * D, tid);
                PH_END
                PH_BEGIN
                    {
                        EpiResidual<false, true> E{XB, XB, modl + 2 * D, 32};
                        run_gemm(lds, Z, WB + W_BOUT / 2 + (size_t)j * D * D, TL, D, D, E);
                        if (ctx_live) { EpiPartF32 E0{CPART}, E1{CPART + (size_t)TC * D};
                            run_gemm_slice(lds, Z + (size_t)TL * D, WB + W_BOUT / 2 + (size_t)j * D * D, TC, D, 0, 512, D, 0, E0);
                            run_gemm_slice(lds, Z + (size_t)TL * D, WB + W_BOUT / 2 + (size_t)j * D * D, TC, D, 512, 512, D, 128, E1); }
                    }
                PH_END
            }
            {
                bf16_t* Abuf = (bf16_t*)(BIG + BIG_A); bf16_t* GVC = (bf16_t*)(BIG + BIG_GVC);
                const bf16_t* Wup = WB + W_UP / 2 + (size_t)i * 2 * DFF * D; const bf16_t* Wdn = WB + W_DN / 2 + (size_t)i * D * DFF;
                const int nrows = ctx_live ? TT : TL;
                PH_BEGIN
norm_phase<false, true>((const float*)XB, i == 0 ? P.ctx : CTXRES, CTXRES, CPART, ctx_live ? 2 : 0, modl + 4 * MODW + 2 * D, nrows, P.g_ffn + (size_t)i * D, modl, 3 * D, 4 * D, HX, nullptr, nullptr, nullptr, lds, tid, wave, lane);
                PH_END
                PH_BEGIN
{ EpiConvGLU E{Abuf, P.f_w_conv + (size_t)i * 3 * DFF, P.f_b_conv + (size_t)i * DFF}; run_gemm<EpiConvGLU, ColStripA>(lds, HX, Wup, TL, 2 * DFF, D, E); }
                    if (ctx_live) { EpiStoreBf16 Ec{GVC, 2 * DFF, 0, 0}; run_gemm(lds, HX + (size_t)TL * D, Wup, TC, 2 * DFF, D, Ec); }
                PH_END
                if (ctx_live) {
                    PH_BEGIN
                        act_phase(GVC, Abuf + (size_t)TL * DFF, P.f_w_conv + (size_t)i * 3 * DFF, P.f_b_conv + (size_t)i * DFF, TC, true, tid);
                    PH_END
                }
                PH_BEGIN
                    {
                        { EpiResidual<false, true> E{XB, i == 3 ? XF : XB, modl + 5 * D, 32}; run_gemm(lds, Abuf, Wdn, TL, D, DFF, E); }
                        if (ctx_live) {
                            EpiPartF32 E0{CPART}, E1{CPART + (size_t)TC * D}, E2{CPART + (size_t)2 * TC * D}, E3{CPART + (size_t)3 * TC * D};
                            run_gemm_slice(lds, Abuf + (size_t)TL * DFF, Wdn, TC, D, 0, 768, DFF, 0, E0);
                            run_gemm_slice(lds, Abuf + (size_t)TL * DFF, Wdn, TC, D, 768, 768, DFF, 64, E1);
                            run_gemm_slice(lds, Abuf + (size_t)TL * DFF, Wdn, TC, D, 1536, 640, DFF, 128, E2);
                            run_gemm_slice(lds, Abuf + (size_t)TL * DFF, Wdn, TC, D, 2176, 640, DFF, 192, E3); }
                    }
                PH_END
            }
        }
    }
    PH_BEGIN
        final_norm(XF, P.out, P.g_final, wave, lane);
    PH_END
#undef PH_BEGIN
#undef PH_END
}

extern "C" void kernel_launch(void* const* d_in, const int* in_sizes, int n_in, void* d_out, int out_size, void* d_ws, size_t ws_size, hipStream_t stream) {
    static int grid = 0;
    if (grid == 0) {
        if (n_in != 20 || out_size != TL * D || ws_size < WS_END) { fprintf(stderr, "kernel_launch: unexpected problem (n_in %d, out %d, ws %zu < %zu)\n", n_in, out_size, ws_size, (size_t)WS_END); grid = -1; return; }
        int dev = 0, cus = 0, per_cu = 0;
        if (hipGetDevice(&dev) != hipSuccess || hipDeviceGetAttribute(&cus, hipDeviceAttributeMultiprocessorCount, dev) != hipSuccess) { grid = -1; return; }
        if (hipFuncSetAttribute((const void*)fwd_kernel, hipFuncAttributeMaxDynamicSharedMemorySize, LDS_BYTES) != hipSuccess) { grid = -1; return; }
        if (hipOccupancyMaxActiveBlocksPerMultiprocessor(&per_cu, (const void*)fwd_kernel, NTHR, LDS_BYTES) != hipSuccess || per_cu < 1) { fprintf(stderr, "kernel_launch: occupancy query says %d\n", per_cu); }
        (void)hipGetLastError();
        grid = cus;
    }
    if (grid < 0) return;
    (void)hipMemsetAsync((char*)d_ws + WS_CTL, 0, CTL_ZERO_BYTES, stream);
    Args a{};
    const float* const* in = (const float* const*)d_in;
    a.p.x = in[0]; a.p.c = in[1]; a.p.ctx = in[2]; a.p.c_ctx = in[3]; a.p.w_mod = in[4]; a.p.b_mod = in[5]; a.p.g_mix = in[6]; a.p.g_ffn = in[7];
    a.p.a_w_in = in[8]; a.p.a_b_gate = in[9]; a.p.a_head_gain = in[10]; a.p.a_w_out = in[11]; a.p.b_w_in = in[12]; a.p.b_w_conv = in[13]; a.p.b_w_out = in[14];
    a.p.f_w_up = in[15]; a.p.f_w_conv = in[16]; a.p.f_b_conv = in[17]; a.p.f_w_down = in[18]; a.p.g_final = in[19];
    a.p.out = (float*)d_out; a.p.ws = (unsigned char*)d_ws;
#if MK_MULTI
    for (int p = 0; p < NPHASES; ++p) { a.ph_lo = p; a.ph_hi = p + 1; hipLaunchKernelGGL(fwd_kernel, dim3(grid), dim3(NTHR), LDS_BYTES, stream, a); }
#else
    a.ph_lo = 0; a.ph_hi = NPHASES;
    hipLaunchKernelGGL(fwd_kernel, dim3(grid), dim3(NTHR), LDS_BYTES, stream, a);
#endif
}
```
